# Optimizing an MI355X kernel written in HIP

```python
import jax, jax.numpy as jnp
from jax import lax
import numpy as np

D_MODEL = 1024
BATCH = 8
SEQ = 2048
DEPTH = 2
DEC_BATCH = 1
DEC_SEQ = 16384
PAST_LEN = 128

GRID_W = 64
N_MIXERS = 2
NA_HEADS = 16
NA_HEAD_DIM = 64
NA_WIN_ROWS = 8
NA_WIN_COLS = 16
NA_COL_BLOCK = 16
NA_KEY_COLS = 32
GQA_Q_HEADS = 8
GQA_KV_HEADS = 4
GQA_GROUP = GQA_Q_HEADS // GQA_KV_HEADS
GQA_HEAD_DIM = 128
GQA_Q_BLOCK = 128
ROPE_THETA = 10000.0
PLE_DIM = 256
D_FF = ((8 * D_MODEL // 3 + 255) // 256) * 256
EPS = 1e-6
NEG_INF = -1e30

kernel_name = "hybrid_natten_gqa_sandwich_ple_encoder"


def _rms(x):
    xf = x.astype(jnp.float32)
    return xf * lax.rsqrt(jnp.mean(xf * xf, axis=-1, keepdims=True) + EPS)


def rms_norm(x, g):
    return (_rms(x) * g.astype(jnp.float32)).astype(x.dtype)


def _na_static_tables():
    n_cb = GRID_W // NA_COL_BLOCK
    qcol = np.arange(GRID_W).reshape(n_cb, NA_COL_BLOCK)
    kstart = np.clip(np.arange(n_cb) * NA_COL_BLOCK - NA_WIN_COLS // 2, 0, GRID_W - NA_KEY_COLS)
    kcol = kstart[:, None] + np.arange(NA_KEY_COLS)
    wstart = np.clip(qcol - NA_WIN_COLS // 2, 0, GRID_W - NA_WIN_COLS)
    kc = kcol[:, None, :]
    col_mask = (kc >= wstart[..., None]) & (kc < wstart[..., None] + NA_WIN_COLS)
    col_off = np.clip(kc - qcol[..., None] + NA_WIN_COLS - 1, 0, 2 * NA_WIN_COLS - 2)
    return n_cb, kcol, col_mask, col_off


def neighborhood_attention(h, w_qkv, rpb, w_o):
    B, L, _ = h.shape
    rows = L // GRID_W
    kr = min(NA_WIN_ROWS, rows)
    n_cb, kcol, col_mask, col_off = _na_static_tables()
    qkv = (h @ w_qkv).reshape(B, rows, GRID_W, 3, NA_HEADS, NA_HEAD_DIM)
    q = qkv[:, :, :, 0] * (NA_HEAD_DIM ** -0.5)
    k = qkv[:, :, :, 1]
    v = qkv[:, :, :, 2]
    qcb = q.reshape(B, rows, n_cb, NA_COL_BLOCK, NA_HEADS, NA_HEAD_DIM)
    kcb = k[:, :, kcol]
    vcb = v[:, :, kcol]
    rpb_cols = rpb[:, :, col_off]
    mask = jnp.asarray(col_mask)[:, :, None, :]

    def row_fn(r):
        rs = jnp.clip(r - kr // 2, 0, rows - kr)
        kb = lax.dynamic_slice_in_dim(kcb, rs, kr, axis=1)
        vb = lax.dynamic_slice_in_dim(vcb, rs, kr, axis=1)
        qr = lax.dynamic_index_in_dim(qcb, r, axis=1, keepdims=False)
        s = jnp.einsum('bjqhd,bujkhd->bhjquk', qr, kb, preferred_element_type=jnp.float32)
        row_idx = rs + jnp.arange(kr) - r + NA_WIN_ROWS - 1
        bias = jnp.take(rpb_cols, row_idx, axis=1).astype(jnp.float32)
        bias = bias.transpose(0, 2, 3, 1, 4)
        s = jnp.where(mask, s + bias[None], NEG_INF)
        s_shape = s.shape
        p = jax.nn.softmax(s.reshape(s_shape[:4] + (kr * NA_KEY_COLS,)), axis=-1).reshape(s_shape)
        return jnp.einsum('bhjquk,bujkhd->bjqhd', p.astype(vb.dtype), vb)

    o = lax.map(row_fn, jnp.arange(rows))
    o = o.transpose(1, 0, 2, 3, 4, 5).reshape(B, L, NA_HEADS * NA_HEAD_DIM)
    return o @ w_o


def _axial_rope(L):
    t = jnp.arange(L)
    row = (t // GRID_W).astype(jnp.float32)
    col = (t % GRID_W).astype(jnp.float32)
    axis_dim = GQA_HEAD_DIM // 2
    inv_freq = ROPE_THETA ** (-jnp.arange(0, axis_dim, 2, dtype=jnp.float32) / axis_dim)
    ang = jnp.stack([row[:, None] * inv_freq, col[:, None] * inv_freq], axis=1)
    return jnp.cos(ang), jnp.sin(ang)


def _apply_rope(x, cos, sin):
    B, L, H, _ = x.shape
    n_f = GQA_HEAD_DIM // 4
    xr = x.astype(jnp.float32).reshape(B, L, H, 2, 2, n_f)
    a, b = xr[..., 0, :], xr[..., 1, :]
    c = cos[None, :, None]
    s = sin[None, :, None]
    out = jnp.stack([a * c - b * s, b * c + a * s], axis=-2)
    return out.reshape(B, L, H, GQA_HEAD_DIM).astype(x.dtype)


def gqa_attention(h, w_qkv, q_norm, k_norm, w_o):
    B, L, _ = h.shape
    qd = GQA_Q_HEADS * GQA_HEAD_DIM
    kd = GQA_KV_HEADS * GQA_HEAD_DIM
    qkv = h @ w_qkv
    q = qkv[..., :qd].reshape(B, L, GQA_Q_HEADS, GQA_HEAD_DIM)
    k = qkv[..., qd:qd + kd].reshape(B, L, GQA_KV_HEADS, GQA_HEAD_DIM)
    v = qkv[..., qd + kd:].reshape(B, L, GQA_KV_HEADS, GQA_HEAD_DIM)
    cos, sin = _axial_rope(L)
    q = _apply_rope(rms_norm(q, q_norm), cos, sin) * (GQA_HEAD_DIM ** -0.5)
    k = _apply_rope(rms_norm(k, k_norm), cos, sin)
    nb = L // GQA_Q_BLOCK
    qb = q.reshape(B, nb, GQA_Q_BLOCK, GQA_KV_HEADS, GQA_GROUP, GQA_HEAD_DIM).transpose(1, 0, 2, 3, 4, 5)

    def blk(qi):
        s = jnp.einsum('bqkgd,bskd->bkgqs', qi, k, preferred_element_type=jnp.float32)
        p = jax.nn.softmax(s, axis=-1).astype(v.dtype)
        return jnp.einsum('bkgqs,bskd->bqkgd', p, v)

    o = lax.map(blk, qb)
    o = o.transpose(1, 0, 2, 3, 4, 5).reshape(B, L, GQA_Q_HEADS * GQA_HEAD_DIM)
    return o @ w_o


def swiglu(h, w_gate_up, w_down):
    gu = h @ w_gate_up
    g, u = gu[..., :D_FF], gu[..., D_FF:]
    return (jax.nn.silu(g) * u) @ w_down


def trunk(x, p, mix_pre_norm, mix_post_norm, ffn_pre_norm, ffn_post_norm,
          na_w_qkv, na_rpb, na_w_o, gqa_w_qkv, gqa_q_norm, gqa_k_norm, gqa_w_o,
          ffn_w_gate_up, ffn_w_down, ple_w_gate, ple_w_proj):
    h = x
    for i in range(DEPTH):
        j = i // N_MIXERS
        a = rms_norm(h, mix_pre_norm[i])
        if i % N_MIXERS == 0:
            m = neighborhood_attention(a, na_w_qkv[j], na_rpb[j], na_w_o[j])
        else:
            m = gqa_attention(a, gqa_w_qkv[j], gqa_q_norm[j], gqa_k_norm[j], gqa_w_o[j])
        h = h + rms_norm(m, mix_post_norm[i])
        f = swiglu(rms_norm(h, ffn_pre_norm[i]), ffn_w_gate_up[i], ffn_w_down[i])
        h = h + rms_norm(f, ffn_post_norm[i])
        gate = jax.nn.sigmoid(_rms(h).astype(h.dtype) @ ple_w_gate[i])
        h = h + (p[i] @ ple_w_proj[i]) * gate
    return h


def setup_inputs(seed: int = 0) -> dict:
    key = jax.random.key(seed)
    ks = jax.random.split(key, 20)
    n_a = (DEPTH + 1) // 2
    n_b = DEPTH // 2
    f32 = jnp.float32
    nrm = lambda k, shape, scale: jax.random.normal(k, shape, f32) * scale
    gain = lambda k, shape: 1.0 + 0.05 * jax.random.normal(k, shape, f32)
    na_w = NA_HEADS * NA_HEAD_DIM
    gqa_w = (GQA_Q_HEADS + 2 * GQA_KV_HEADS) * GQA_HEAD_DIM
    return {
        "x_prompt": jax.random.normal(ks[0], (BATCH, SEQ, D_MODEL), f32),
        "x_sample": jax.random.normal(ks[1], (DEC_BATCH, DEC_SEQ, D_MODEL), f32),
        "p_prompt": jax.random.normal(ks[2], (DEPTH, BATCH, SEQ, PLE_DIM), f32),
        "p_sample": jax.random.normal(ks[3], (DEPTH, DEC_BATCH, DEC_SEQ, PLE_DIM), f32),
        "mix_pre_norm": gain(ks[4], (DEPTH, D_MODEL)),
        "mix_post_norm": gain(ks[5], (DEPTH, D_MODEL)),
        "ffn_pre_norm": gain(ks[6], (DEPTH, D_MODEL)),
        "ffn_post_norm": gain(ks[7], (DEPTH, D_MODEL)),
        "na_w_qkv": nrm(ks[8], (n_a, D_MODEL, 3 * na_w), D_MODEL ** -0.5),
        "na_rpb": nrm(ks[9], (n_a, NA_HEADS, 2 * NA_WIN_ROWS - 1, 2 * NA_WIN_COLS - 1), 0.5),
        "na_w_o": nrm(ks[10], (n_a, na_w, D_MODEL), na_w ** -0.5),
        "gqa_w_qkv": nrm(ks[11], (n_b, D_MODEL, gqa_w), D_MODEL ** -0.5),
        "gqa_q_norm": gain(ks[12], (n_b, GQA_HEAD_DIM)),
        "gqa_k_norm": gain(ks[13], (n_b, GQA_HEAD_DIM)),
        "gqa_w_o": nrm(ks[14], (n_b, GQA_Q_HEADS * GQA_HEAD_DIM, D_MODEL), (GQA_Q_HEADS * GQA_HEAD_DIM) ** -0.5),
        "ffn_w_gate_up": nrm(ks[15], (DEPTH, D_MODEL, 2 * D_FF), D_MODEL ** -0.5),
        "ffn_w_down": nrm(ks[16], (DEPTH, D_FF, D_MODEL), D_FF ** -0.5),
        "ple_w_gate": nrm(ks[17], (DEPTH, D_MODEL, D_MODEL), D_MODEL ** -0.5),
        "ple_w_proj": nrm(ks[18], (DEPTH, PLE_DIM, D_MODEL), PLE_DIM ** -0.5),
    }


def reference(x_prompt, x_sample, p_prompt, p_sample, mix_pre_norm, mix_post_norm,
              ffn_pre_norm, ffn_post_norm, na_w_qkv, na_rpb, na_w_o, gqa_w_qkv,
              gqa_q_norm, gqa_k_norm, gqa_w_o, ffn_w_gate_up, ffn_w_down,
              ple_w_gate, ple_w_proj):
    y_prompt = trunk(x_prompt, p_prompt, mix_pre_norm, mix_post_norm, ffn_pre_norm, ffn_post_norm,
                     na_w_qkv, na_rpb, na_w_o, gqa_w_qkv, gqa_q_norm, gqa_k_norm, gqa_w_o,
                     ffn_w_gate_up, ffn_w_down, ple_w_gate, ple_w_proj)
    y_sample = trunk(x_sample, p_sample, mix_pre_norm, mix_post_norm, ffn_pre_norm, ffn_post_norm,
                     na_w_qkv, na_rpb, na_w_o, gqa_w_qkv, gqa_q_norm, gqa_k_norm, gqa_w_o,
                     ffn_w_gate_up, ffn_w_down, ple_w_gate, ple_w_proj)
    return (y_prompt, y_sample)
```

```cpp
#include <hip/hip_runtime.h>
#include <hip/hip_cooperative_groups.h>
#include <hip/hip_bf16.h>
#include <cstdio>
#include <cstdint>
#include <cmath>
namespace cg = cooperative_groups;

#ifndef MK_PER_PHASE
#define MK_PER_PHASE 0
#endif
namespace pg8 {
#define PG8_LAS __attribute__((address_space(3)))
typedef unsigned short bf16_t;
typedef short bf16x8 __attribute__((ext_vector_type(8)));
typedef float f32x4 __attribute__((ext_vector_type(4)));
typedef unsigned u32x4 __attribute__((ext_vector_type(4)));
constexpr int BM = 256, BK = 64, HALF = 128, HTB = HALF * BK * 2  , STAGE_BYTES = 8 * HTB, NXCD = 8, WGM = 4;

__host__ __device__ __forceinline__ int lds_byte(int r, int c) { const int st = (r >> 4) * 2 + (c >> 5), rr = r & 15, cc = c & 31, ob = rr * 64 + cc * 2; return st * 1024 + (ob ^ (((ob >> 9) & 1) << 5)); }
__host__ __device__ __forceinline__ void stage_rc(int b, int& R, int& C) { const int st = b / 1024, sb = b % 1024, swz = sb ^ (((sb >> 9) & 1) << 5); R = (st >> 1) * 16 + swz / 64; C = (st & 1) * 32 + (swz % 64) / 2; }
__host__ __device__ __forceinline__ int perm32(int rho) { const int n = rho >> 4, i = rho & 15; return 8 * (i >> 2) + 4 * n + (i & 3); }

struct Unit { int pm, pn; };
struct Gemm { const bf16_t* A; const bf16_t* Bt; int M, N, K; };

struct StaticOrder {
    int nM, nN, nwg, G, c;
    __host__ __device__ void init(int M, int N, int G_, int c_) { nM = M / BM; nN = N / BM; nwg = nM * nN; G = G_; c = c_; }
    __host__ __device__ bool next(int i, Unit& u) const {
        const long L = (long)i * G + c; if (L >= nwg) return false;
        int wgid = (int)L; { const int q = nwg / NXCD, r = nwg % NXCD, xcd = wgid % NXCD, off = wgid / NXCD; wgid = (xcd < r ? xcd * (q + 1) : r * (q + 1) + (xcd - r) * q) + off; }
        const int nig = WGM * nN, gid = wgid / nig, fm = gid * WGM, gsz = (nM - fm) < WGM ? (nM - fm) : WGM;
        u.pm = fm + ((wgid % nig) % gsz); u.pn = (wgid % nig) / gsz; return true;
    }
    __device__ __forceinline__ void a_ready(const Unit&) const {}
    __device__ __forceinline__ void done(const Unit&) const {}
};

__device__ __forceinline__ unsigned cvt_pk_bf16(float lo, float hi) { unsigned r; asm volatile("v_cvt_pk_bf16_f32 %0, %1, %2" : "=v"(r) : "v"(lo), "v"(hi)); return r; }
typedef float f32x2 __attribute__((ext_vector_type(2)));
typedef unsigned u32x2 __attribute__((ext_vector_type(2)));
__device__ __forceinline__ float bf_lo(unsigned w) { return __uint_as_float(w << 16); }
__device__ __forceinline__ float bf_hi(unsigned w) { return __uint_as_float(w & 0xffff0000u); }
__device__ __forceinline__ float sigmoid_f(float x) { return __builtin_amdgcn_rcpf(1.0f + __builtin_amdgcn_exp2f(-1.4426950408889634f * x)); }

template <bool ROWSCALE> struct EpiStore {
    static constexpr bool PERM = true, AFTER_DRAIN = false;
    bf16_t* O; int ldc; int qcols; float qscale; const float* SS;
    __device__ __forceinline__ void operator()(const f32x4 (&acc)[2][2][4][2], const Unit& u, int wr, int wc, int fr, int fq) const {
        const int row0 = u.pm * BM + wr * 64 + fr; const int colt = u.pn * BM;
        const float sc0 = (colt < qcols) ? qscale : 1.f;
        const int col0 = colt + wc * 32 + 8 * fq;
#pragma unroll
        for (int ai = 0; ai < 2; ++ai)
#pragma unroll
            for (int m = 0; m < 4; ++m) { const int row = row0 + ai * HALF + m * 16; bf16_t* rowp = O + (size_t)row * ldc + col0;
                float sc = sc0; if (ROWSCALE) sc *= 1.0f / sqrtf(SS[row] * (1.0f / 1024.0f) + 1e-6f);
#pragma unroll
                for (int bj = 0; bj < 2; ++bj) { const f32x4 v0 = acc[ai][bj][m][0] * sc, v1 = acc[ai][bj][m][1] * sc;
                    u32x4 w; w.x = cvt_pk_bf16(v0[0], v0[1]); w.y = cvt_pk_bf16(v0[2], v0[3]); w.z = cvt_pk_bf16(v1[0], v1[1]); w.w = cvt_pk_bf16(v1[2], v1[3]);
                    *(u32x4*)(rowp + bj * HALF) = w; } }
    }
};
struct EpiSwiglu {
    static constexpr bool PERM = true, AFTER_DRAIN = false;
    bf16_t* O; int ldc;
    __device__ __forceinline__ void operator()(const f32x4 (&acc)[2][2][4][2], const Unit& u, int wr, int wc, int fr, int fq) const {
        const int row0 = u.pm * BM + wr * 64 + fr; const int col0 = u.pn * HALF + wc * 32 + 8 * fq;
#pragma unroll
        for (int ai = 0; ai < 2; ++ai)
#pragma unroll
            for (int m = 0; m < 4; ++m) { bf16_t* rowp = O + (size_t)(row0 + ai * HALF + m * 16) * ldc + col0;
                float r[8];
#pragma unroll
                for (int n = 0; n < 2; ++n)
#pragma unroll
                    for (int e = 0; e < 4; ++e) { const float g = acc[ai][0][m][n][e], up = acc[ai][1][m][n][e]; r[n * 4 + e] = g * sigmoid_f(g) * up; }
                u32x4 w; w.x = cvt_pk_bf16(r[0], r[1]); w.y = cvt_pk_bf16(r[2], r[3]); w.z = cvt_pk_bf16(r[4], r[5]); w.w = cvt_pk_bf16(r[6], r[7]);
                *(u32x4*)rowp = w; }
    }
};
template <int MODE> struct EpiGate {
    static constexpr bool PERM = true, AFTER_DRAIN = false;
    const bf16_t* Hin; const bf16_t* PP; bf16_t* Hout; float* Fout; bf16_t* A2; const float* gpre; float* SS;
    __device__ __forceinline__ void operator()(const f32x4 (&acc)[2][2][4][2], const Unit& u, int wr, int wc, int fr, int fq) const {
        const int row0 = u.pm * BM + wr * 64 + fr; const int col0 = u.pn * BM + wc * 32 + 8 * fq;
        float gp[2][8];
        if (MODE == 2) {
#pragma unroll
            for (int bj = 0; bj < 2; ++bj) { const f32x4 g0 = *(const f32x4*)(gpre + col0 + bj * HALF), g1 = *(const f32x4*)(gpre + col0 + bj * HALF + 4);
#pragma unroll
                for (int e = 0; e < 4; ++e) { gp[bj][e] = g0[e]; gp[bj][4 + e] = g1[e]; } }
        }
#pragma unroll
        for (int ai = 0; ai < 2; ++ai)
#pragma unroll
            for (int m = 0; m < 4; ++m) { const int row = row0 + ai * HALF + m * 16; const size_t off = (size_t)row * 1024 + col0; float rs = 0.f;
#pragma unroll
                for (int bj = 0; bj < 2; ++bj) { const size_t c = off + bj * HALF;
                    const u32x4 hw = *(const u32x4*)(Hin + c); const u32x4 pw = *(const u32x4*)(PP + c);
                    float o[8];
#pragma unroll
                    for (int n = 0; n < 2; ++n)
#pragma unroll
                        for (int w = 0; w < 2; ++w) { const unsigned hh = hw[2 * n + w], pp = pw[2 * n + w]; const f32x4 a = acc[ai][bj][m][n];
                            o[4 * n + 2 * w] = bf_lo(hh) + bf_lo(pp) * sigmoid_f(a[2 * w]); o[4 * n + 2 * w + 1] = bf_hi(hh) + bf_hi(pp) * sigmoid_f(a[2 * w + 1]); }
                    if (MODE == 1) { *(f32x4*)(Fout + c) = (f32x4){o[0], o[1], o[2], o[3]}; *(f32x4*)(Fout + c + 4) = (f32x4){o[4], o[5], o[6], o[7]}; }
                    else { u32x4 w; w.x = cvt_pk_bf16(o[0], o[1]); w.y = cvt_pk_bf16(o[2], o[3]); w.z = cvt_pk_bf16(o[4], o[5]); w.w = cvt_pk_bf16(o[6], o[7]); *(u32x4*)(Hout + c) = w; }
                    if (MODE == 2) {
#pragma unroll
                        for (int e = 0; e < 8; ++e) rs += o[e] * o[e];
                        u32x4 w; w.x = cvt_pk_bf16(o[0] * gp[bj][0], o[1] * gp[bj][1]); w.y = cvt_pk_bf16(o[2] * gp[bj][2], o[3] * gp[bj][3]);
                        w.z = cvt_pk_bf16(o[4] * gp[bj][4], o[5] * gp[bj][5]); w.w = cvt_pk_bf16(o[6] * gp[bj][6], o[7] * gp[bj][7]); *(u32x4*)(A2 + c) = w; } }
                if (MODE == 2) { rs += __shfl_xor(rs, 16); rs += __shfl_xor(rs, 32); if (fq == 0) atomicAdd(SS + row, rs); } }
    }
};
template <class Epi, class Sched, bool ALIGN_EPI = false, bool SP2 = false>
__device__ __forceinline__ void gemm_phase(PG8_LAS unsigned char* lds, const Gemm g, const Sched& S, const Epi& E) {
    const int tid = threadIdx.x, wid = __builtin_amdgcn_readfirstlane(tid >> 6), lane = tid & 63, wr = wid >> 2, wc = wid & 3, fr = lane & 15, fq = lane >> 4;
    const int K = g.K, nt = K / BK;
    unsigned voffA[2], voffB[2];
#pragma unroll
    for (int i = 0; i < 2; ++i) { int R, C; stage_rc(tid * 16 + i * 8192, R, C); const int Rb = Epi::PERM ? ((R & ~31) + perm32(R & 31)) : R;
        voffA[i] = (unsigned)(R * K + C) * 2u; voffB[i] = (unsigned)(Rb * K + C) * 2u; }
    const size_t kstep = (size_t)(BK * 2);
    const size_t hstep = (size_t)HALF * K * 2;
    const size_t tstep = 2 * hstep;
    const unsigned ldsw = (unsigned)wid * 1024u;
    const int aoff = lds_byte(wr * 64 + fr, fq * 8), boff = lds_byte(wc * 32 + fr, fq * 8);
#define PG8_SA(b, h) (((b) * 2 + (h)) * HTB)
#define PG8_SB(b, h) ((4 + (b) * 2 + (h)) * HTB)
#define PG8_STAGE(bufoff, gbase, voff) do { _Pragma("unroll") for (int _i = 0; _i < 2; ++_i) \
        __builtin_amdgcn_global_load_lds((const unsigned*)((const char*)(gbase) + (voff)[_i]), (PG8_LAS unsigned*)(lds + (bufoff) + ldsw + _i * 8192), 16, 0, 0); } while (0)
#define PG8_LDA(dst, b, h) do { _Pragma("unroll") for (int m = 0; m < 4; ++m) _Pragma("unroll") for (int k = 0; k < 2; ++k) dst[m][k] = *(const PG8_LAS bf16x8*)(lds + PG8_SA(b, h) + aoff + m * 2048 + k * 1024); } while (0)
#define PG8_LDB(dst, b, h) do { _Pragma("unroll") for (int n = 0; n < 2; ++n) _Pragma("unroll") for (int k = 0; k < 2; ++k) dst[n][k] = *(const PG8_LAS bf16x8*)(lds + PG8_SB(b, h) + boff + n * 2048 + k * 1024); } while (0)
#define PG8_MMA(ai, bj, At, Bt) do { __builtin_amdgcn_s_setprio(1); _Pragma("unroll") for (int m = 0; m < 4; ++m) _Pragma("unroll") for (int n = 0; n < 2; ++n) _Pragma("unroll") for (int k = 0; k < 2; ++k) \
        acc[ai][bj][m][n] = __builtin_amdgcn_mfma_f32_16x16x32_bf16(Bt[n][k], At[m][k], acc[ai][bj][m][n], 0, 0, 0); __builtin_amdgcn_s_setprio(0); } while (0)
#define PG8_WAIT_V(n) asm volatile("s_waitcnt vmcnt(" #n ")" ::: "memory")
#define PG8_WAIT_L(n) asm volatile("s_waitcnt lgkmcnt(" #n ")" ::: "memory")
#define PG8_BAR __builtin_amdgcn_s_barrier()
#define PG8_SCHED __builtin_amdgcn_sched_barrier(0)
    Unit cur, nxt; int ui = 0;
    if (!S.next(0, cur)) return;
    f32x4 acc[2][2][4][2];
#pragma unroll
    for (int a = 0; a < 2; ++a)
#pragma unroll
        for (int b = 0; b < 2; ++b)
#pragma unroll
            for (int m = 0; m < 4; ++m)
#pragma unroll
                for (int n = 0; n < 2; ++n) acc[a][b][m][n] = (f32x4){0.f, 0.f, 0.f, 0.f};
    bf16x8 At[4][2], B0[2][2], B1[2][2];
    const char* cA = (const char*)g.A + (size_t)cur.pm * tstep; const char* cB = (const char*)g.Bt + (size_t)cur.pn * tstep;
    S.a_ready(cur);
    if constexpr (SP2) {
        PG8_STAGE(PG8_SB(0, 0), cB, voffB); PG8_STAGE(PG8_SB(0, 1), cB + hstep, voffB); PG8_STAGE(PG8_SA(0, 0), cA, voffA); PG8_STAGE(PG8_SA(0, 1), cA + hstep, voffA);
        if (wr == 1) PG8_BAR;
        PG8_WAIT_V(2); PG8_BAR;
        PG8_STAGE(PG8_SB(1, 0), cB + kstep, voffB); PG8_STAGE(PG8_SA(1, 0), cA + kstep, voffA); PG8_STAGE(PG8_SB(1, 1), cB + hstep + kstep, voffB);
        PG8_WAIT_V(6); PG8_BAR;
    } else {
        PG8_STAGE(PG8_SB(0, 0), cB, voffB); PG8_STAGE(PG8_SA(0, 0), cA, voffA); PG8_STAGE(PG8_SB(0, 1), cB + hstep, voffB); PG8_STAGE(PG8_SA(0, 1), cA + hstep, voffA);
        if (wr == 1) PG8_BAR;
        PG8_WAIT_V(4); PG8_BAR;
        PG8_STAGE(PG8_SB(1, 0), cB + kstep, voffB); PG8_STAGE(PG8_SA(1, 0), cA + kstep, voffA); PG8_STAGE(PG8_SB(1, 1), cB + hstep + kstep, voffB);
        PG8_WAIT_V(6); PG8_BAR;
    }
    for (;;) {
        const bool has_next = S.next(ui + 1, nxt);
        const char* nA = has_next ? (const char*)g.A + (size_t)nxt.pm * tstep : cA; const char* nB = has_next ? (const char*)g.Bt + (size_t)nxt.pn * tstep : cB;
        for (int t = 0; t < nt; t += 2) {
            const bool last = (t == nt - 2);
            const char* a1 = cA + (size_t)(t + 1) * kstep;
            const char* a2 = last ? nA : cA + (size_t)(t + 2) * kstep; const char* b2 = last ? nB : cB + (size_t)(t + 2) * kstep;
            const char* a3 = a2 + kstep; const char* b3 = b2 + kstep;
            if (last && has_next) S.a_ready(nxt);
            if constexpr (SP2) {
            PG8_LDB(B0, 0, 0); PG8_LDB(B1, 0, 1); PG8_SCHED; PG8_LDA(At, 0, 0); PG8_STAGE(PG8_SA(1, 1), a1 + hstep, voffA);
            PG8_WAIT_V(8); PG8_WAIT_L(0); PG8_BAR; PG8_MMA(0, 0, At, B0); PG8_MMA(0, 1, At, B1); PG8_BAR; PG8_SCHED;
            PG8_LDA(At, 0, 1); PG8_STAGE(PG8_SB(0, 0), b2, voffB); PG8_STAGE(PG8_SB(0, 1), b2 + hstep, voffB); PG8_STAGE(PG8_SA(0, 0), a2, voffA);
            PG8_WAIT_V(8); PG8_WAIT_L(0); PG8_BAR; PG8_MMA(1, 0, At, B0); PG8_MMA(1, 1, At, B1); PG8_BAR; PG8_SCHED;
            PG8_LDB(B0, 1, 0); PG8_LDB(B1, 1, 1); PG8_SCHED; PG8_LDA(At, 1, 0); PG8_STAGE(PG8_SA(0, 1), a2 + hstep, voffA);
            PG8_WAIT_V(8); PG8_WAIT_L(0); PG8_BAR; PG8_MMA(0, 0, At, B0); PG8_MMA(0, 1, At, B1); PG8_BAR; PG8_SCHED;
            PG8_LDA(At, 1, 1); PG8_STAGE(PG8_SB(1, 0), b3, voffB); PG8_STAGE(PG8_SB(1, 1), b3 + hstep, voffB); PG8_STAGE(PG8_SA(1, 0), a3, voffA);
            PG8_WAIT_V(8); PG8_WAIT_L(0); PG8_BAR; PG8_MMA(1, 0, At, B0); PG8_MMA(1, 1, At, B1); PG8_BAR; PG8_SCHED;
            } else {
            PG8_LDB(B0, 0, 0); PG8_SCHED; PG8_LDA(At, 0, 0); PG8_STAGE(PG8_SA(1, 1), a1 + hstep, voffA);
            PG8_WAIT_L(8); PG8_BAR; PG8_WAIT_L(0); PG8_MMA(0, 0, At, B0); PG8_BAR; PG8_SCHED;
            PG8_LDB(B1, 0, 1); PG8_STAGE(PG8_SB(0, 0), b2, voffB);
            PG8_BAR; PG8_WAIT_L(0); PG8_MMA(0, 1, At, B1); PG8_BAR;
            PG8_LDA(At, 0, 1); PG8_STAGE(PG8_SA(0, 0), a2, voffA);
            PG8_BAR; PG8_WAIT_L(0); PG8_MMA(1, 0, At, B0); PG8_BAR; PG8_SCHED;
            PG8_STAGE(PG8_SB(0, 1), b2 + hstep, voffB);
            PG8_WAIT_V(6); PG8_BAR; PG8_MMA(1, 1, At, B1); PG8_BAR;
            PG8_LDB(B0, 1, 0); PG8_SCHED; PG8_LDA(At, 1, 0); PG8_STAGE(PG8_SA(0, 1), a2 + hstep, voffA);
            PG8_WAIT_L(8); PG8_BAR; PG8_WAIT_L(0); PG8_MMA(0, 0, At, B0); PG8_BAR; PG8_SCHED;
            PG8_LDB(B1, 1, 1); PG8_STAGE(PG8_SB(1, 0), b3, voffB);
            PG8_BAR; PG8_WAIT_L(0); PG8_MMA(0, 1, At, B1); PG8_BAR;
            PG8_LDA(At, 1, 1); PG8_STAGE(PG8_SA(1, 0), a3, voffA);
            PG8_BAR; PG8_WAIT_L(0); PG8_MMA(1, 0, At, B0); PG8_BAR; PG8_SCHED;
            PG8_STAGE(PG8_SB(1, 1), b3 + hstep, voffB);
            PG8_WAIT_V(6); PG8_BAR; PG8_MMA(1, 1, At, B1); PG8_BAR;
            }
        }
        if constexpr (ALIGN_EPI) { if (wr == 0) PG8_BAR; }
        if constexpr (!Epi::AFTER_DRAIN) { E(acc, cur, wr, wc, fr, fq); S.done(cur); }
        if (!has_next) break;
#pragma unroll
        for (int a = 0; a < 2; ++a)
#pragma unroll
            for (int b = 0; b < 2; ++b)
#pragma unroll
                for (int m = 0; m < 4; ++m)
#pragma unroll
                    for (int n = 0; n < 2; ++n) acc[a][b][m][n] = (f32x4){0.f, 0.f, 0.f, 0.f};
        cur = nxt; cA = nA; cB = nB; ++ui;
        if constexpr (ALIGN_EPI) { if (wr == 1) PG8_BAR; }
    }
    PG8_WAIT_V(0);
    if constexpr (!ALIGN_EPI) { if (wr == 0) PG8_BAR; }
    PG8_BAR;
    if constexpr (Epi::AFTER_DRAIN) { E.fused(acc, cur, wr, wc, fr, fq, lds, wid, lane); S.done(cur); }
#undef PG8_SA
#undef PG8_SB
#undef PG8_STAGE
#undef PG8_LDA
#undef PG8_LDB
#undef PG8_MMA
#undef PG8_WAIT_V
#undef PG8_WAIT_L
#undef PG8_BAR
#undef PG8_SCHED
}
}
namespace att {
using bf16 = __hip_bfloat16;
constexpr int   D = 128, NW = 8, QBLK = 32, KVBLK = 64;
constexpr float SCALE = 0.088388347648318440f;
constexpr float THR = 8.f;
constexpr int SDEPTH = 1;
constexpr int LDQ = 2048, LDK = 128, LDO = 1024;
constexpr size_t SHM_V = KVBLK * D * 2, SHM_K = KVBLK * D * 2, SHM_ATTN = 3 * SHM_V + 3 * SHM_K + NW * 64 * 4;
using bf16x8 = __attribute__((ext_vector_type(8))) short;
using s16x4  = __attribute__((ext_vector_type(4))) short;
using f32x16 = __attribute__((ext_vector_type(16))) float;
using f32x8  = __attribute__((ext_vector_type(8))) float;
using u32x4  = __attribute__((ext_vector_type(4))) unsigned;
#define KSWZ(row, colB) ((row) * 256 + ((colB) ^ (((row) & 7) << 4)))
#define SBAR() __builtin_amdgcn_sched_barrier(0)
__device__ __forceinline__ int crow(int r, int hi) { return (r & 3) + 8 * (r >> 2) + 4 * hi; }
__device__ __forceinline__ unsigned cvtpk(float lo, float hi) {
  unsigned r; asm volatile("v_cvt_pk_bf16_f32 %0, %1, %2" : "=v"(r) : "v"(lo), "v"(hi)); return r;
}
template <typename TIn> struct Stage;
template <> struct Stage<bf16>  { using T = bf16x8;
  __device__ static __forceinline__ T ld8(const bf16* p) { return *reinterpret_cast<const bf16x8*>(p); }
  __device__ static __forceinline__ bf16x8 tobf(T x) { return x; } };
template <> struct Stage<float> { using T = f32x8;
  __device__ static __forceinline__ T ld8(const float* p) { return *reinterpret_cast<const f32x8*>(p); }
  __device__ static __forceinline__ bf16x8 tobf(T x) {
    u32x4 w = {cvtpk(x[0], x[1]), cvtpk(x[2], x[3]), cvtpk(x[4], x[5]), cvtpk(x[6], x[7])}; return *reinterpret_cast<bf16x8*>(&w); } };

__device__ __forceinline__ float rowmax32(const f32x16& p0, const f32x16& p1) {
  float pmax = p0[0]; for (int r = 1; r < 16; ++r) pmax = fmaxf(pmax, p0[r]); for (int r = 0; r < 16; ++r) pmax = fmaxf(pmax, p1[r]);
  auto rr = __builtin_amdgcn_permlane32_swap(__float_as_uint(pmax), __float_as_uint(pmax), false, false);
  return fmaxf(__uint_as_float(rr[0]), __uint_as_float(rr[1]));
}
__device__ __forceinline__ void partialSM_first(f32x16& p0, f32x16& p1, float& m_reg) {
  const float pmax = rowmax32(p0, p1); m_reg = pmax;
  for (int r = 0; r < 16; ++r) p0[r] -= pmax; for (int r = 0; r < 16; ++r) p1[r] -= pmax;
  for (int r = 0; r < 16; ++r) p0[r] = __builtin_amdgcn_exp2f(p0[r]);
}
__device__ __forceinline__ void partialSM_fix(f32x16& p0) { for (int r = 0; r < 16; ++r) p0[r] = __builtin_amdgcn_exp2f(p0[r]); }
__device__ __forceinline__ void partialSM(f32x16& p0, f32x16& p1, float& m_reg, float& alpha) {
  constexpr float THRL = THR * 1.4426950408889634f;
  const float pmax = rowmax32(p0, p1);
  if (__builtin_expect(__all(pmax <= THRL), 1)) { alpha = 1.f; }
  else { const float dl = fmaxf(pmax, 0.f); m_reg += dl; alpha = __builtin_amdgcn_exp2f(-dl);
    for (int r = 0; r < 16; ++r) p0[r] -= dl; for (int r = 0; r < 16; ++r) p1[r] -= dl; }
  for (int r = 0; r < 16; ++r) p0[r] = __builtin_amdgcn_exp2f(p0[r]);
}
__device__ __forceinline__ void finishSM(f32x16& p0, f32x16& p1, float alpha, float& l_reg, bf16x8& pa0, bf16x8& pa1, bf16x8& pa2, bf16x8& pa3) {
  for (int r = 0; r < 16; ++r) p1[r] = __builtin_amdgcn_exp2f(p1[r]);
  float ps = 0; for (int r = 0; r < 16; ++r) ps += p0[r]; for (int r = 0; r < 16; ++r) ps += p1[r];
  { auto rr = __builtin_amdgcn_permlane32_swap(__float_as_uint(ps), __float_as_uint(ps), false, false);
    ps = __uint_as_float(rr[0]) + __uint_as_float(rr[1]); }
  l_reg = l_reg * alpha + ps;
#define PK4(P, BASE, OUT) do { unsigned a0 = cvtpk(P[BASE + 0], P[BASE + 1]), a1 = cvtpk(P[BASE + 2], P[BASE + 3]);   \
    unsigned b0 = cvtpk(P[BASE + 4], P[BASE + 5]), b1 = cvtpk(P[BASE + 6], P[BASE + 7]);                              \
    auto r0 = __builtin_amdgcn_permlane32_swap(a0, b0, false, false); auto r1 = __builtin_amdgcn_permlane32_swap(a1, b1, false, false); \
    u32x4 w = {r0[0], r1[0], r0[1], r1[1]}; OUT = *reinterpret_cast<bf16x8*>(&w); } while (0)
  PK4(p0, 0, pa0); PK4(p0, 8, pa1); PK4(p1, 0, pa2); PK4(p1, 8, pa3);
#undef PK4
}
__device__ __forceinline__ void qkt(f32x16& p0, f32x16& p1, const bf16* Ks, const bf16x8* qr, int r32, int hi) {
  p0 = f32x16{}; p1 = f32x16{};
  for (int d0 = 0; d0 < 8; ++d0) { int cb = (d0 * 16 + hi * 8) * 2;
    bf16x8 b0 = *reinterpret_cast<const bf16x8*>((const char*)Ks + KSWZ(r32, cb));
    bf16x8 b1 = *reinterpret_cast<const bf16x8*>((const char*)Ks + KSWZ(32 + r32, cb));
    p0 = __builtin_amdgcn_mfma_f32_32x32x16_bf16(b0, qr[d0], p0, 0, 0, 0);
    p1 = __builtin_amdgcn_mfma_f32_32x32x16_bf16(b1, qr[d0], p1, 0, 0, 0); }
}
__device__ __forceinline__ int v_st(int k, int c) { const int kk = (k & ~0xC) | ((k & 4) << 1) | ((k & 8) >> 1); return ((kk >> 3) * 4 + (c >> 5)) * 512 + ((kk & 7) * 32 + (c & 31)) * 2; }
__device__ __forceinline__ int v_rd_base(int lane) { return ((lane & 3) << 3) | (((lane >> 2) & 3) << 6) | (((lane >> 4) & 1) << 5) | (((lane >> 5) & 1) << 8); }
constexpr int v_rd_off(int d0, int ks, int half) { return d0 * 512 + ks * 4096 + half * 2048; }
template <int OFF> __device__ __forceinline__ s16x4 tr_read(int vb) {
  s16x4 r; asm volatile("ds_read_b64_tr_b16 %0, %1 offset:%2" : "=&v"(r) : "v"(vb), "i"(OFF) : "memory"); return r;
}
template <int D0> __device__ __forceinline__ void pv_one(f32x16& od, int vb, bf16x8 pa0, bf16x8 pa1, bf16x8 pa2, bf16x8 pa3) {
  const s16x4 l0 = tr_read<v_rd_off(D0, 0, 0)>(vb), h0 = tr_read<v_rd_off(D0, 0, 1)>(vb), l1 = tr_read<v_rd_off(D0, 1, 0)>(vb), h1 = tr_read<v_rd_off(D0, 1, 1)>(vb);
  const s16x4 l2 = tr_read<v_rd_off(D0, 2, 0)>(vb), h2 = tr_read<v_rd_off(D0, 2, 1)>(vb), l3 = tr_read<v_rd_off(D0, 3, 0)>(vb), h3 = tr_read<v_rd_off(D0, 3, 1)>(vb);
  asm volatile("s_waitcnt lgkmcnt(0)" ::: "memory"); SBAR();
#define PK(L, H) (bf16x8){L[0], L[1], L[2], L[3], H[0], H[1], H[2], H[3]}
  od = __builtin_amdgcn_mfma_f32_32x32x16_bf16(pa0, PK(l0, h0), od, 0, 0, 0);
  od = __builtin_amdgcn_mfma_f32_32x32x16_bf16(pa1, PK(l1, h1), od, 0, 0, 0);
  od = __builtin_amdgcn_mfma_f32_32x32x16_bf16(pa2, PK(l2, h2), od, 0, 0, 0);
  od = __builtin_amdgcn_mfma_f32_32x32x16_bf16(pa3, PK(l3, h3), od, 0, 0, 0);
#undef PK
}
__device__ __forceinline__ void pv_d0(f32x16* o, int vb, bf16x8 pa0, bf16x8 pa1, bf16x8 pa2, bf16x8 pa3) {
  pv_one<0>(o[0], vb, pa0, pa1, pa2, pa3); pv_one<1>(o[1], vb, pa0, pa1, pa2, pa3); pv_one<2>(o[2], vb, pa0, pa1, pa2, pa3); pv_one<3>(o[3], vb, pa0, pa1, pa2, pa3);
}
template <typename TQ>
__device__ __forceinline__ void attn_dense_body(const TQ* __restrict__ Qb, const bf16* __restrict__ Kh, const bf16* __restrict__ Vh,
                                                bf16* __restrict__ Ob, int seq, char* lds) {
  using St = Stage<bf16>; using SQ = Stage<TQ>;
  const int tid = threadIdx.x, wid = tid >> 6, lane = tid & 63, r32 = lane & 31, hi = lane >> 5;
  bf16* V_lds = (bf16*)lds; bf16* K_lds = (bf16*)(lds + 3 * SHM_V);
  float* ws = (float*)(lds + 3 * SHM_V + 3 * SHM_K) + wid * 64; float* li_l = ws;
    float l_reg = 0; f32x16 o[4] = {}; bf16x8 qr[8];
  const TQ* Qw = Qb + (long)(wid * QBLK + r32) * LDQ + hi * 8;
#pragma unroll
  for (int d0 = 0; d0 < 8; ++d0) qr[d0] = SQ::tobf(SQ::ld8(Qw + d0 * 16));
  const int sr = tid >> 4, sc = (tid & 15) * 8, vst0 = v_st(sr, sc), vst1 = v_st(32 + sr, sc);
  const int vb0 = (int)(uintptr_t)V_lds + v_rd_base(lane);
  struct { typename St::T vs0, vs1, ks0, ks1; } sr_[SDEPTH];
#define SLOAD(i, k0) do { sr_[i].vs0 = St::ld8(&Vh[(long)((k0) + sr) * LDK + sc]); sr_[i].vs1 = St::ld8(&Vh[(long)((k0) + 32 + sr) * LDK + sc]); \
    sr_[i].ks0 = St::ld8(&Kh[(long)((k0) + sr) * LDK + sc]); sr_[i].ks1 = St::ld8(&Kh[(long)((k0) + 32 + sr) * LDK + sc]); } while (0)
#define SWRITE(b, i) do { *(bf16x8*)((char*)V_lds + (b) * SHM_V + vst0) = St::tobf(sr_[i].vs0);          \
    *(bf16x8*)((char*)V_lds + (b) * SHM_V + vst1) = St::tobf(sr_[i].vs1); int kc = sc * 2;               \
    *(bf16x8*)((char*)K_lds + (b) * SHM_K + KSWZ(sr, kc)) = St::tobf(sr_[i].ks0);                       \
    *(bf16x8*)((char*)K_lds + (b) * SHM_K + KSWZ(32 + sr, kc)) = St::tobf(sr_[i].ks1); } while (0)
#define SWAIT() do { if constexpr (SDEPTH == 2) asm volatile("s_waitcnt vmcnt(4)" ::: "memory"); else asm volatile("s_waitcnt vmcnt(0)" ::: "memory"); } while (0)
  f32x16 pA0, pA1, pB0, pB1; constexpr float alA = 1.f, alB = 1.f; bf16x8 pa0, pa1, pa2, pa3; const int NT = seq / KVBLK;
  constexpr int SE = 0, SO = 0;
  SLOAD(SE, 0); asm volatile("s_waitcnt vmcnt(0)" ::: "memory"); SWRITE(0, SE);
  SLOAD(SO, KVBLK);
  __syncthreads();
  qkt(pA0, pA1, K_lds, qr, r32, hi); partialSM_fix(pA0);
  SWAIT(); SWRITE(1, SO); SLOAD(SE, 2 * KVBLK);
  __syncthreads();
  int prev = 0, cur = 1, next = 2;
  for (int j = 1; j + 1 < NT; j += 2) {
    SBAR(); qkt(pB0, pB1, (bf16*)((char*)K_lds + cur * (int)SHM_K), qr, r32, hi);
    finishSM(pA0, pA1, alA, l_reg, pa0, pa1, pa2, pa3); SBAR();
    SWAIT(); SWRITE(next, SE);
    if (j + 2 < NT) SLOAD(SO, (j + 2) * KVBLK); SBAR();
    pv_d0(o, vb0 + prev * (int)SHM_V, pa0, pa1, pa2, pa3); partialSM_fix(pB0);
    __syncthreads();
    { const int t_ = prev; prev = cur; cur = next; next = t_; }
    SBAR(); qkt(pA0, pA1, (bf16*)((char*)K_lds + cur * (int)SHM_K), qr, r32, hi);
    finishSM(pB0, pB1, alB, l_reg, pa0, pa1, pa2, pa3); SBAR();
    if (j + 2 < NT) { SWAIT(); SWRITE(next, SO); }
    if (j + 3 < NT) SLOAD(SE, (j + 3) * KVBLK); SBAR();
    pv_d0(o, vb0 + prev * (int)SHM_V, pa0, pa1, pa2, pa3); partialSM_fix(pA0);
    __syncthreads();
    { const int t_ = prev; prev = cur; cur = next; next = t_; }
  }
  SBAR(); qkt(pB0, pB1, (bf16*)((char*)K_lds + cur * (int)SHM_K), qr, r32, hi);
  finishSM(pA0, pA1, alA, l_reg, pa0, pa1, pa2, pa3); SBAR();
  pv_d0(o, vb0 + prev * (int)SHM_V, pa0, pa1, pa2, pa3); partialSM_fix(pB0);
  finishSM(pB0, pB1, alB, l_reg, pa0, pa1, pa2, pa3); SBAR();
  pv_d0(o, vb0 + cur * (int)SHM_V, pa0, pa1, pa2, pa3);
  if (hi == 0) li_l[r32] = l_reg; asm volatile("s_waitcnt lgkmcnt(0)" ::: "memory");
  float rli[16];
#pragma unroll
  for (int r = 0; r < 16; ++r) rli[r] = __builtin_amdgcn_rcpf(li_l[crow(r, hi)]);
  bf16* Ow = Ob + (long)(wid * QBLK) * LDO;
#pragma unroll
  for (int r = 0; r < 16; ++r) { int orow = crow(r, hi);
    for (int d0 = 0; d0 < 4; ++d0) Ow[(long)orow * LDO + d0 * 32 + r32] = __float2bfloat16(o[d0][r] * rli[r]); }
#undef SLOAD
#undef SWRITE
#undef SWAIT
}
}
#define LAS __attribute__((address_space(3)))
typedef unsigned short bf16_t;
typedef float f32x4 __attribute__((ext_vector_type(4)));
typedef short bf16x8 __attribute__((ext_vector_type(8)));
typedef short s16x4 __attribute__((ext_vector_type(4)));
typedef unsigned u32x4 __attribute__((ext_vector_type(4)));
typedef unsigned u32x2 __attribute__((ext_vector_type(2)));
constexpr int DM = 1024, TP = 16384, TT = 32768, DFF = 2816, PLE = 256, NAQKV = 3072, GQKV = 2048;
constexpr int NTHREADS = 512, NWAVES = 8;
constexpr float RMS_EPS = 1e-6f;
constexpr int N_PHASES = 19;

constexpr size_t SZ_W_NAQKV = (size_t)NAQKV * DM * 2, SZ_W_SQ = (size_t)DM * DM * 2, SZ_W_GQKV = (size_t)GQKV * DM * 2, SZ_W_GU = (size_t)2 * DFF * DM * 2,
                 SZ_W_DN = (size_t)DM * DFF * 2, SZ_W_PP = (size_t)DM * PLE * 2;
constexpr size_t WS_W_NAQKV = 0, WS_W_NAO = WS_W_NAQKV + SZ_W_NAQKV, WS_W_GQKV = WS_W_NAO + SZ_W_SQ, WS_W_GO = WS_W_GQKV + SZ_W_GQKV,
                 WS_W_GU = WS_W_GO + SZ_W_SQ  , WS_W_DN = WS_W_GU + 2 * SZ_W_GU  , WS_W_PG = WS_W_DN + 2 * SZ_W_DN  ,
                 WS_W_PP = WS_W_PG + 2 * SZ_W_SQ  , WS_W_END = WS_W_PP + 2 * SZ_W_PP;
constexpr size_t MiB = 1u << 20;
static_assert(WS_W_END <= 56 * MiB, "weights region");
constexpr size_t WS_A = 56 * MiB;
constexpr size_t WS_QKV = WS_A + 64 * MiB;
constexpr size_t WS_O = WS_QKV + 192 * MiB;
constexpr size_t WS_MB = WS_O + 64 * MiB;
constexpr size_t WS_PB = WS_MB + 64 * MiB;
constexpr size_t WS_CTL = WS_PB + 32 * MiB;
constexpr size_t WS_TAB = WS_CTL + 65536;
constexpr size_t WS_SS = WS_CTL + 131072;
constexpr size_t WS_A2 = WS_QKV + 128 * MiB;
constexpr size_t WS_KC = WS_QKV + 128 * MiB, WS_VC = WS_KC + 32 * MiB;
constexpr size_t WS_END = WS_CTL + 1 * MiB;
constexpr int MISC_OFF = 131072 + 256;
constexpr int LDS_BYTES = 135168;

__device__ __forceinline__ float wave_sum(float v) {
#pragma unroll
    for (int o = 1; o < 64; o <<= 1) v += __shfl_xor(v, o);
    return v;
}
__device__ __forceinline__ unsigned f2bf(float f) { unsigned u = __builtin_bit_cast(unsigned, f); return (u + 0x7fffu + ((u >> 16) & 1u)) >> 16; }
__device__ __forceinline__ unsigned pk2(float lo, float hi) { return f2bf(lo) | (f2bf(hi) << 16); }
__device__ __forceinline__ float bflo(unsigned w) { return __uint_as_float(w << 16); }
__device__ __forceinline__ float bfhi(unsigned w) { return __uint_as_float(w & 0xffff0000u); }

struct TItem { const float* W; bf16_t* WT; int K, N, item, perm; };
__device__ __forceinline__ void t_load(const TItem& d, int lane, float (&v)[32]) {
    const int nblk = d.N / 32, kb = d.item / nblk, nb = d.item % nblk, k0 = 64 * kb, n0 = 32 * nb;
    int s0 = n0;
    if (d.perm) { const int pn = n0 >> 8, rem = n0 & 255; s0 = (rem >> 7) * DFF + pn * 128 + (rem & 127); }
    const float* p = d.W + (size_t)(k0 + (lane >> 5)) * d.N + s0 + (lane & 31);
#pragma unroll
    for (int i = 0; i < 32; ++i) v[i] = p[(size_t)(2 * i) * d.N];
}
__device__ __forceinline__ void t_stage(int lane, const float (&v)[32], LAS float* scr) {
#pragma unroll
    for (int i = 0; i < 32; ++i) scr[(2 * i + (lane >> 5)) * 33 + (lane & 31)] = v[i];
    asm volatile("s_waitcnt lgkmcnt(0)" ::: "memory");
}
__device__ __forceinline__ void t_store(const TItem& d, int lane, LAS float* scr) {
    const int nblk = d.N / 32, kb = d.item / nblk, nb = d.item % nblk, k0 = 64 * kb, n0 = 32 * nb;
    const int c = lane & 7;
#pragma unroll
    for (int j = 0; j < 4; ++j) { const int n = (lane >> 3) + 8 * j; const LAS float* s = scr + (8 * c) * 33 + n;
        u32x4 o; o.x = pk2(s[0 * 33], s[1 * 33]); o.y = pk2(s[2 * 33], s[3 * 33]); o.z = pk2(s[4 * 33], s[5 * 33]); o.w = pk2(s[6 * 33], s[7 * 33]);
        *(u32x4*)(d.WT + (size_t)(n0 + n) * d.K + k0 + 8 * c) = o; }
    asm volatile("s_waitcnt lgkmcnt(0)" ::: "memory");
}

template <bool HIN_F32>
__device__ __forceinline__ void rp_load(int row, int lane, const float* hin0, const float* hin1, const bf16_t* Hin, const bf16_t* MB, float (&h)[2][8], u32x4 (&mw)[2]) {
    if (HIN_F32) {
        const float* hr = (row < TP) ? hin0 + (size_t)row * DM : hin1 + (size_t)(row - TP) * DM;
#pragma unroll
        for (int j = 0; j < 2; ++j) { const f32x4 a = *(const f32x4*)(hr + 8 * lane + 512 * j), b = *(const f32x4*)(hr + 8 * lane + 512 * j + 4);
#pragma unroll
            for (int e2 = 0; e2 < 4; ++e2) { h[j][e2] = a[e2]; h[j][4 + e2] = b[e2]; } }
    } else {
#pragma unroll
        for (int j = 0; j < 2; ++j) { const u32x4 w = *(const u32x4*)(Hin + (size_t)row * DM + 8 * lane + 512 * j);
#pragma unroll
            for (int e2 = 0; e2 < 4; ++e2) { h[j][2 * e2] = bflo(w[e2]); h[j][2 * e2 + 1] = bfhi(w[e2]); } }
    }
    if (MB) {
#pragma unroll
        for (int j = 0; j < 2; ++j) mw[j] = *(const u32x4*)(MB + (size_t)row * DM + 8 * lane + 512 * j);
    }
}
__device__ __forceinline__ void rp_finish(int row, int lane, float (&h)[2][8], const u32x4 (&mw)[2], bf16_t* Hout, bool hasM, const float* gpost, const float* gpre, bf16_t* Aout) {
    if (hasM) {
        float m[2][8]; float ss = 0.f;
#pragma unroll
        for (int j = 0; j < 2; ++j)
#pragma unroll
            for (int e2 = 0; e2 < 4; ++e2) { const float lo = bflo(mw[j][e2]), hi = bfhi(mw[j][e2]); m[j][2 * e2] = lo; m[j][2 * e2 + 1] = hi; ss += lo * lo + hi * hi; }
        const float r = 1.0f / sqrtf(wave_sum(ss) * (1.0f / DM) + RMS_EPS);
#pragma unroll
        for (int j = 0; j < 2; ++j) { const f32x4 g0 = *(const f32x4*)(gpost + 8 * lane + 512 * j), g1 = *(const f32x4*)(gpost + 8 * lane + 512 * j + 4);
#pragma unroll
            for (int e2 = 0; e2 < 4; ++e2) { h[j][e2] += m[j][e2] * r * g0[e2]; h[j][4 + e2] += m[j][4 + e2] * r * g1[e2]; }
            u32x4 w; w.x = pk2(h[j][0], h[j][1]); w.y = pk2(h[j][2], h[j][3]); w.z = pk2(h[j][4], h[j][5]); w.w = pk2(h[j][6], h[j][7]);
            *(u32x4*)(Hout + (size_t)row * DM + 8 * lane + 512 * j) = w; }
    }
    float s2 = 0.f;
#pragma unroll
    for (int j = 0; j < 2; ++j)
#pragma unroll
        for (int e2 = 0; e2 < 8; ++e2) s2 += h[j][e2] * h[j][e2];
    const float r2 = 1.0f / sqrtf(wave_sum(s2) * (1.0f / DM) + RMS_EPS);
#pragma unroll
    for (int j = 0; j < 2; ++j) { float o[8];
#pragma unroll
        for (int e2 = 0; e2 < 8; ++e2) o[e2] = h[j][e2] * r2;
        if (gpre) { const f32x4 g0 = *(const f32x4*)(gpre + 8 * lane + 512 * j), g1 = *(const f32x4*)(gpre + 8 * lane + 512 * j + 4);
#pragma unroll
            for (int e2 = 0; e2 < 4; ++e2) { o[e2] *= g0[e2]; o[4 + e2] *= g1[e2]; } }
        u32x4 w; w.x = pk2(o[0], o[1]); w.y = pk2(o[2], o[3]); w.z = pk2(o[4], o[5]); w.w = pk2(o[6], o[7]);
        *(u32x4*)(Aout + (size_t)row * DM + 8 * lane + 512 * j) = w; }
}
template <bool HIN_F32>
__device__ __forceinline__ void rowpass(int gw, int ngw, int lane, const float* hin0, const float* hin1, const bf16_t* Hin, bf16_t* Hout, const bf16_t* MB, const float* gpost, const float* gpre, bf16_t* Aout) {
    constexpr int NR = 4;
    for (int row = gw; row < TT; row += NR * ngw) {
        float hh[NR][2][8]; u32x4 mm[NR][2];
#pragma unroll
        for (int q = 0; q < NR; ++q) if (row + q * ngw < TT) rp_load<HIN_F32>(row + q * ngw, lane, hin0, hin1, Hin, MB, hh[q], mm[q]);
#pragma unroll
        for (int q = 0; q < NR; ++q) if (row + q * ngw < TT) rp_finish(row + q * ngw, lane, hh[q], mm[q], Hout, MB != nullptr, gpost, gpre, Aout);
    }
}

__device__ __forceinline__ void qk_norm_rope(int gw, int ngw, int lane, bf16_t* QKV, bf16_t* Kc, bf16_t* Vc, const float* tab, const float* qn, const float* kn) {
    const int hh = lane >> 2, c4 = lane & 3;
    const float qsc = (hh < 8) ? 0.12751743082459868f : 1.0f;
    float g[4][8];
    { const float* gsrc = (hh < 8) ? qn : kn;
#pragma unroll
      for (int ch = 0; ch < 4; ++ch) { const f32x4 g0 = *(const f32x4*)(gsrc + ch * 32 + c4 * 8), g1 = *(const f32x4*)(gsrc + ch * 32 + c4 * 8 + 4);
#pragma unroll
          for (int e2 = 0; e2 < 4; ++e2) { g[ch][e2] = g0[e2]; g[ch][4 + e2] = g1[e2]; } } }
    constexpr int NR = 4;
    for (int t0 = gw; t0 < TT; t0 += NR * ngw) {
        u32x4 xx[NR][4];
#pragma unroll
        for (int q = 0; q < NR; ++q) { const int t = t0 + q * ngw;
            if (t < TT) { const bf16_t* src = QKV + (size_t)t * GQKV + hh * 128 + c4 * 8;
#pragma unroll
                for (int ch = 0; ch < 4; ++ch) xx[q][ch] = *(const u32x4*)(src + ch * 32); } }
#pragma unroll
        for (int q = 0; q < NR; ++q) { const int t = t0 + q * ngw;
          if (t < TT) {
            const int tin = (t < TP) ? (t & 2047) : (t - TP);
            const int prow = tin >> 6, pcol = tin & 63;
            if (hh >= 12) {
                bf16_t* dst = Vc + ((size_t)(hh - 12) * TT + t) * 128 + c4 * 8;
#pragma unroll
                for (int ch = 0; ch < 4; ++ch) *(u32x4*)(dst + ch * 32) = xx[q][ch];
            } else {
                float v[4][8]; float ss = 0.f;
#pragma unroll
                for (int ch = 0; ch < 4; ++ch)
#pragma unroll
                    for (int w = 0; w < 4; ++w) { const float lo = bflo(xx[q][ch][w]), hi = bfhi(xx[q][ch][w]); v[ch][2 * w] = lo; v[ch][2 * w + 1] = hi; ss += lo * lo + hi * hi; }
                ss += __shfl_xor(ss, 1); ss += __shfl_xor(ss, 2);
                const float r = qsc / sqrtf(ss * (1.0f / 128.0f) + RMS_EPS);
                u32x4 y[4];
#pragma unroll
                for (int ax = 0; ax < 2; ++ax) {
                    const f32x4* tp = (const f32x4*)(tab + ((ax ? pcol : prow) * 32 + c4 * 8) * 2);
                    u32x4 oa, ob;
#pragma unroll
                    for (int w = 0; w < 4; ++w) {
                        const f32x4 cs2 = tp[w];
                        const float a0 = v[2 * ax][2 * w] * r * g[2 * ax][2 * w], b0 = v[2 * ax + 1][2 * w] * r * g[2 * ax + 1][2 * w];
                        const float a1 = v[2 * ax][2 * w + 1] * r * g[2 * ax][2 * w + 1], b1 = v[2 * ax + 1][2 * w + 1] * r * g[2 * ax + 1][2 * w + 1];
                        oa[w] = pk2(a0 * cs2[0] - b0 * cs2[1], a1 * cs2[2] - b1 * cs2[3]);
                        ob[w] = pk2(b0 * cs2[0] + a0 * cs2[1], b1 * cs2[2] + a1 * cs2[3]);
                    }
                    y[2 * ax] = oa; y[2 * ax + 1] = ob;
                }
                bf16_t* dst = (hh < 8) ? QKV + (size_t)t * GQKV + hh * 128 + c4 * 8 : Kc + ((size_t)(hh - 8) * TT + t) * 128 + c4 * 8;
#pragma unroll
                for (int ch = 0; ch < 4; ++ch) *(u32x4*)(dst + ch * 32) = y[ch];
            }
          } }
    }
}

__device__ __forceinline__ s16x4 tr16(unsigned addr) {
    typedef short v4i16_t __attribute__((ext_vector_type(4)));
    return __builtin_bit_cast(s16x4, __builtin_amdgcn_ds_read_tr16_b64_v4i16((LAS v4i16_t*)addr));
}
__device__ __forceinline__ unsigned cvtpk(float lo, float hi) { unsigned r; asm volatile("v_cvt_pk_bf16_f32 %0, %1, %2" : "=v"(r) : "v"(lo), "v"(hi)); return r; }
struct NaUnit { int j, h, tok0, rows, r0, rs_lo, nchunks, kstart; };
__device__ __forceinline__ NaUnit na_decode(int unit) {
    NaUnit u; u.j = unit & 3; u.h = (unit >> 2) & 15; const int g = unit >> 6; int rc;
    if (g < 32) { u.tok0 = (g >> 2) * 2048; u.rows = 32; rc = g & 3; } else { u.tok0 = TP; u.rows = 256; rc = g - 32; }
    u.r0 = rc * 8;
    u.rs_lo = min(max(u.r0 - 4, 0), u.rows - 8); const int rs_hi = min(max(u.r0 + 3, 0), u.rows - 8);
    u.nchunks = (rs_hi + 8 - u.rs_lo) * 256;
    u.kstart = min(max(16 * u.j - 8, 0), 32);
    return u;
}
#define NA_LOAD(U) do { _Pragma("unroll") for (int i = 0; i < 8; ++i) { const int idx = tid + i * NTHREADS; \
            if (idx < (U).nchunks) { const int c = idx & 7, key = idx >> 3, krow = key >> 5, kcol = key & 31; \
                const size_t tok = (size_t)((U).tok0 + ((U).rs_lo + krow) * 64 + (U).kstart + kcol); \
                const bf16_t* src = QKV + tok * NAQKV + 1024 + (U).h * 64 + c * 8; \
                kreg[i] = *(const u32x4*)src; vreg[i] = *(const u32x4*)(src + 1024); } } \
        { const bf16_t* qp_ = QKV + (size_t)((U).tok0 + ((U).r0 + wid) * 64 + 16 * (U).j + n16) * NAQKV + (U).h * 64 + kq * 8; qn0 = *(const bf16x8*)qp_; qn1 = *(const bf16x8*)(qp_ + 32); } } while (0)
__device__ __forceinline__ void na_phase(LAS unsigned char* lds, const bf16_t* QKV, const float* rpb, bf16_t* O, int bid, int G) {
    constexpr int K_OFF = 0, V_OFF = 61440, B_OFF = 122880;
    const int tid = threadIdx.x, lane = tid & 63, wid = tid >> 6, n16 = lane & 15, kq = lane >> 4;
    LAS float* bias = (LAS float*)(lds + B_OFF);
    u32x4 kreg[8], vreg[8]; bf16x8 qn0, qn1;
    if (bid < 4096) { const NaUnit u0 = na_decode(bid); NA_LOAD(u0); }
    for (int unit = bid; unit < 4096; unit += G) {
        const NaUnit U = na_decode(unit);
        const int j = U.j, h = U.h, tok0 = U.tok0, rows = U.rows, r0 = U.r0, rs_lo = U.rs_lo, kstart = U.kstart;
#pragma unroll
        for (int i = 0; i < 8; ++i) { const int idx = tid + i * NTHREADS;
            if (idx < U.nchunks) { const int c = idx & 7, key = idx >> 3;
                *(LAS u32x4*)(lds + K_OFF + key * 128 + ((c ^ ((key >> 1) & 7)) << 4)) = kreg[i];
                *(LAS u32x4*)(lds + V_OFF + key * 128 + ((c ^ (((key >> 1) & 3) << 1)) << 4)) = vreg[i]; } }
        if (tid < 465) bias[(tid / 31) * 32 + (tid % 31)] = rpb[h * 465 + tid];
        if (tid >= 480 && tid < 495) bias[(tid - 480) * 32 + 31] = -1.0e30f;
        __syncthreads();
        const int r = r0 + wid, rs = min(max(r - 4, 0), rows - 8), lrow0 = rs - rs_lo;
        const int qcol = 16 * j + n16; const size_t qtok = (size_t)(tok0 + r * 64 + qcol);
        const bf16x8 q0 = qn0, q1 = qn1;
        if (unit + G < 4096) { const NaUnit Un = na_decode(unit + G); NA_LOAD(Un); }
        asm volatile("" ::: "memory");
        f32x4 s[16];
        const int ksw = (n16 >> 1) & 7;
        const LAS unsigned char* kp0 = lds + K_OFF + (lrow0 * 32 + n16) * 128;
        const LAS unsigned char* ka = kp0 + ((kq ^ ksw) << 4); const LAS unsigned char* kb = kp0 + (((4 + kq) ^ ksw) << 4);
#pragma unroll
        for (int t = 0; t < 16; ++t) {
            const bf16x8 k0 = *(const LAS bf16x8*)(ka + t * 2048), k1 = *(const LAS bf16x8*)(kb + t * 2048);
            f32x4 z = {0.f, 0.f, 0.f, 0.f};
            z = __builtin_amdgcn_mfma_f32_16x16x32_bf16(k0, q0, z, 0, 0, 0); z = __builtin_amdgcn_mfma_f32_16x16x32_bf16(k1, q1, z, 0, 0, 0); s[t] = z;
        }
        const int wstart = min(max(qcol - 8, 0), 48);
        int boff[2][4];
#pragma unroll
        for (int h2 = 0; h2 < 2; ++h2)
#pragma unroll
            for (int i = 0; i < 4; ++i) { const int kc = kstart + h2 * 16 + kq * 4 + i; const bool valid = (kc >= wstart) && (kc < wstart + 16); boff[h2][i] = valid ? (kc - qcol + 15) : 31; }
        const LAS float* brow0 = bias + (rs - r + 7) * 32;
        float mx = -3.0e38f;
#pragma unroll
        for (int t = 0; t < 16; ++t)
#pragma unroll
            for (int i = 0; i < 4; ++i) { const float v = s[t][i] + brow0[(t >> 1) * 32 + boff[t & 1][i]]; s[t][i] = v; mx = fmaxf(mx, v); }
        mx = fmaxf(mx, __shfl_xor(mx, 16)); mx = fmaxf(mx, __shfl_xor(mx, 32));
        const float mc = -mx * 1.4426950408889634f;
#pragma unroll
        for (int t = 0; t < 16; ++t)
#pragma unroll
            for (int i = 0; i < 4; ++i) s[t][i] = __builtin_amdgcn_exp2f(fmaf(s[t][i], 1.4426950408889634f, mc));
        f32x4 o[4], osum = (f32x4){0.f, 0.f, 0.f, 0.f};
#pragma unroll
        for (int dt = 0; dt < 4; ++dt) o[dt] = (f32x4){0.f, 0.f, 0.f, 0.f};
        const bf16x8 ones = (bf16x8){0x3F80, 0x3F80, 0x3F80, 0x3F80, 0x3F80, 0x3F80, 0x3F80, 0x3F80};
        const int q4 = n16 >> 2, p4 = n16 & 3;
        const int vsw = ((kq * 4 + q4) >> 1) & 3;
        const unsigned vbase = (unsigned)(uintptr_t)(lds + V_OFF) + (lrow0 * 32 + kq * 4 + q4) * 128 + p4 * 8;
        const unsigned va0 = vbase + ((0 ^ vsw) << 5), va1 = vbase + ((1 ^ vsw) << 5), va2 = vbase + ((2 ^ vsw) << 5), va3 = vbase + ((3 ^ vsw) << 5);
#pragma unroll
        for (int u = 0; u < 8; ++u) {
            u32x4 pw; pw.x = cvtpk(s[2 * u][0], s[2 * u][1]); pw.y = cvtpk(s[2 * u][2], s[2 * u][3]); pw.z = cvtpk(s[2 * u + 1][0], s[2 * u + 1][1]); pw.w = cvtpk(s[2 * u + 1][2], s[2 * u + 1][3]);
            const bf16x8 pf = __builtin_bit_cast(bf16x8, pw);
            osum = __builtin_amdgcn_mfma_f32_16x16x32_bf16(ones, pf, osum, 0, 0, 0);
#pragma unroll
            for (int dt = 0; dt < 4; ++dt) {
                const unsigned addr = (dt == 0 ? va0 : dt == 1 ? va1 : dt == 2 ? va2 : va3) + u * 4096;
                const s16x4 lo = tr16(addr), hi = tr16(addr + 2048);
                const bf16x8 vf = (bf16x8){lo[0], lo[1], lo[2], lo[3], hi[0], hi[1], hi[2], hi[3]};
                o[dt] = __builtin_amdgcn_mfma_f32_16x16x32_bf16(vf, pf, o[dt], 0, 0, 0);
            }
        }
        const float l = osum[0];
        const float inv = 1.0f / l;
        bf16_t* op = O + qtok * DM + h * 64 + kq * 4;
#pragma unroll
        for (int dt = 0; dt < 4; ++dt) { u32x2 w; w.x = cvtpk(o[dt][0] * inv, o[dt][1] * inv); w.y = cvtpk(o[dt][2] * inv, o[dt][3] * inv); *(u32x2*)(op + dt * 16) = w; }
        __syncthreads();
    }
}

#define XB_TMO      128
#define XB_XCNT(j)  (256  + 64 * (j))
#define XB_XSUB(j)  (1280 + 64 * (j))
#define XB_XGEN(j)  (2304 + 64 * (j))
#define XB_TOP      3328
#define XB_TOPGEN   3392
#define XCD_BAR_WORDS 3456
#define XB_SPIN_CAP (1u << 21)

__device__ __forceinline__ unsigned xb_ld(unsigned* p)              { return __hip_atomic_load(p, __ATOMIC_RELAXED, __HIP_MEMORY_SCOPE_AGENT); }
__device__ __forceinline__ unsigned xb_add(unsigned* p, unsigned v) { return __hip_atomic_fetch_add(p, v, __ATOMIC_RELAXED, __HIP_MEMORY_SCOPE_AGENT); }
__device__ __forceinline__ unsigned xb_xcc_id() { return (unsigned)__builtin_amdgcn_s_getreg((3 << 11) | 20) & 0xFu; }
#define XB_SPIN(cond, bar) do { unsigned _sp = 0; while (cond) { __builtin_amdgcn_s_sleep(1); \
    if ((++_sp & 255u) == 0u) { if (xb_ld(&(bar)[XB_TMO])) break; if (_sp > XB_SPIN_CAP) { atomicAdd(&(bar)[XB_TMO], 1u); break; } } } } while (0)

struct XcdBarrier {
    unsigned* bar; unsigned x;
    volatile LAS unsigned* st;
};

__device__ __forceinline__ XcdBarrier xcd_barrier_post(unsigned* bar, volatile LAS unsigned* st) {
    XcdBarrier b; b.bar = bar; b.x = xb_xcc_id(); b.st = st;
    if (threadIdx.x == 0) (void)xb_add(&bar[XB_XCNT(b.x)], 1u);
    return b;
}
__device__ __forceinline__ void xcd_barrier_complete(unsigned* bar, unsigned x, unsigned& nloc, unsigned& nx) {
    const unsigned G = gridDim.x * gridDim.y * gridDim.z;
    unsigned sum, cnt, mine, sp = 0u;
    for (;;) {
        sum = 0u; cnt = 0u; mine = 0u;
#pragma unroll
        for (unsigned j = 0; j < 16; ++j) { const unsigned c = xb_ld(&bar[XB_XCNT(j)]); sum += c; cnt += (c > 0u) ? 1u : 0u; mine = (j == x) ? c : mine; }
        if (sum == G) break;
        __builtin_amdgcn_s_sleep(1);
        if ((++sp & 255u) == 0u) { if (xb_ld(&bar[XB_TMO])) break; if (sp > XB_SPIN_CAP) { atomicAdd(&bar[XB_TMO], 1u); break; } }
    }
    nloc = mine > 0u ? mine : 1u; nx = cnt > 0u ? cnt : 1u;
}

__device__ __forceinline__ void xcd_barrier(const XcdBarrier& b) {
    asm volatile("s_waitcnt vmcnt(0)" ::: "memory");
    __syncthreads();
    if (threadIdx.x == 0) {
        unsigned* bar = b.bar;
        __builtin_amdgcn_s_waitcnt(0);
        unsigned nloc = b.st[0], nx = b.st[1];
        if (nloc == 0u) { xcd_barrier_complete(bar, b.x, nloc, nx); b.st[0] = nloc; b.st[1] = nx; }
        const unsigned old = xb_add(&bar[XB_XSUB(b.x)], 1u);
        const unsigned gen = old / nloc;
        if (old + 1u == (gen + 1u) * nloc) {
            __builtin_amdgcn_fence(__ATOMIC_RELEASE, "agent");
            asm volatile("s_waitcnt vmcnt(0)" ::: "memory");
            const unsigned og = xb_add(&bar[XB_TOP], 1u);
            const unsigned tg = og / nx;
            if (og + 1u == (tg + 1u) * nx) xb_add(&bar[XB_TOPGEN], 1u);
            else XB_SPIN(xb_ld(&bar[XB_TOPGEN]) == tg, bar);
            __builtin_amdgcn_fence(__ATOMIC_ACQUIRE, "agent");
            xb_add(&bar[XB_XGEN(b.x)], 1u);
            asm volatile("s_waitcnt vmcnt(0)" ::: "memory");
        } else {
            XB_SPIN(xb_ld(&bar[XB_XGEN(b.x)]) == gen, bar);
            __builtin_amdgcn_fence(__ATOMIC_ACQUIRE, "agent");
            asm volatile("s_waitcnt vmcnt(0)" ::: "memory");
        }
    }
    __syncthreads();
}

struct Args { const float* in[19]; float* out; unsigned char* ws; int ph_lo, ph_hi; };

__global__ void __launch_bounds__(NTHREADS, 2) mega_fwd(Args a) {
    extern __shared__ __attribute__((aligned(16))) unsigned char lds_raw[];
    LAS unsigned char* lds = (LAS unsigned char*)lds_raw;
    cg::grid_group grid = cg::this_grid();
    const int tid = threadIdx.x, lane = tid & 63, wave = __builtin_amdgcn_readfirstlane(tid >> 6);
    const int G = gridDim.x, bid = blockIdx.x;
    const int gw = bid * NWAVES + wave, ngw = G * NWAVES;
    unsigned char* ws = a.ws;
    bf16_t* Abuf = (bf16_t*)(ws + WS_A); bf16_t* QKV = (bf16_t*)(ws + WS_QKV); bf16_t* ACT = QKV; bf16_t* Obuf = (bf16_t*)(ws + WS_O); bf16_t* PPb = Obuf;
    bf16_t* Hb = (bf16_t*)(ws + WS_MB); bf16_t* PB = (bf16_t*)(ws + WS_PB);
    bf16_t* MB = (bf16_t*)a.out;
    volatile LAS unsigned* MISC = (volatile LAS unsigned*)(lds + MISC_OFF);
    if (tid < 2) MISC[tid] = 0u;
    unsigned* barw = (unsigned*)(ws + WS_CTL);
    __syncthreads();
    XcdBarrier bar = xcd_barrier_post(barw, MISC);

    const int lo = a.ph_lo, hi = a.ph_hi;
    if (hi > 1000) grid.sync();
#define IN(k) (lo <= (k) && (k) < hi)
#define SEAM(k) do { if ((k) + 1 < hi) xcd_barrier(bar); } while (0)
#define GEMM_STORE(Aptr, Bptr, Nn, Kk, Optr, Ldc, Qcols) do { pg8::Gemm g{(Aptr), (Bptr), TT, (Nn), (Kk)}; pg8::StaticOrder S; S.init(TT, (Nn), G, bid); \
        pg8::EpiStore<false> E{(Optr), (Ldc), (Qcols), 0.125f, nullptr}; pg8::gemm_phase<pg8::EpiStore<false>, pg8::StaticOrder, true, true>(lds, g, S, E); } while (0)
#define GEMM_STORE_RS(Aptr, Bptr, Nn, Kk, Optr, Ldc, SSp) do { pg8::Gemm g{(Aptr), (Bptr), TT, (Nn), (Kk)}; pg8::StaticOrder S; S.init(TT, (Nn), G, bid); \
        pg8::EpiStore<true> E{(Optr), (Ldc), 0, 1.0f, (SSp)}; pg8::gemm_phase<pg8::EpiStore<true>, pg8::StaticOrder, true, true>(lds, g, S, E); } while (0)
#define GEMM_SWIGLU(Bptr) do { pg8::Gemm g{Abuf, (Bptr), TT, 2 * DFF, DM}; pg8::StaticOrder S; S.init(TT, 2 * DFF, G, bid); \
        pg8::EpiSwiglu E{ACT, DFF}; pg8::gemm_phase<pg8::EpiSwiglu, pg8::StaticOrder, true, true>(lds, g, S, E); } while (0)
#define GEMM_GATE(Bptr, MODE) do { pg8::Gemm g{Abuf, (Bptr), TT, DM, DM}; pg8::StaticOrder S; S.init(TT, DM, G, bid); \
        pg8::EpiGate<MODE> E{Hb, PPb, Hb, a.out, (bf16_t*)(ws + WS_A2), a.in[4] + DM, (float*)(ws + WS_SS)}; pg8::gemm_phase<pg8::EpiGate<MODE>, pg8::StaticOrder, true, true>(lds, g, S, E); } while (0)
#define WPTR(off) ((const bf16_t*)(ws + (off)))
#ifndef PROBE_REP
#define PROBE_REP 0
#endif
#define REP(k) for (int rep_ = 0; rep_ < (((PROBE_REP >> (k)) & 1) ? 2 : 1); ++rep_)
#define REPBAR(k) do { if (((PROBE_REP >> (k)) & 1) && rep_ == 0) xcd_barrier(bar); } while (0)

    if (IN(0)) { REP(0) {
        LAS float* scr = (LAS float*)(lds + wave * 16384);
        constexpr int I0 = 16 * 96, I1 = 16 * 32, I2 = 16 * 64, I3 = 16 * 32, I4 = 16 * 176, I6 = 44 * 32, I8 = 16 * 32, I10 = 4 * 32;
        constexpr int NITEMS = I0 + I1 + I2 + I3 + 2 * I4 + 2 * I6 + 2 * I8 + 2 * I10;
#define T_DECODE(D, IT) do { int r = (IT); \
            if (r < I0) { D = TItem{a.in[8], (bf16_t*)(ws + WS_W_NAQKV), DM, NAQKV, r, 0}; } else { r -= I0; \
            if (r < I1) { D = TItem{a.in[10], (bf16_t*)(ws + WS_W_NAO), DM, DM, r, 0}; } else { r -= I1; \
            if (r < I2) { D = TItem{a.in[11], (bf16_t*)(ws + WS_W_GQKV), DM, GQKV, r, 0}; } else { r -= I2; \
            if (r < I3) { D = TItem{a.in[14], (bf16_t*)(ws + WS_W_GO), DM, DM, r, 0}; } else { r -= I3; \
            if (r < 2 * I4) { const int l = r / I4; D = TItem{a.in[15] + (size_t)l * DM * 2 * DFF, (bf16_t*)(ws + WS_W_GU + l * SZ_W_GU), DM, 2 * DFF, r % I4, 1}; } else { r -= 2 * I4; \
            if (r < 2 * I6) { const int l = r / I6; D = TItem{a.in[16] + (size_t)l * DFF * DM, (bf16_t*)(ws + WS_W_DN + l * SZ_W_DN), DFF, DM, r % I6, 0}; } else { r -= 2 * I6; \
            if (r < 2 * I8) { const int l = r / I8; D = TItem{a.in[17] + (size_t)l * DM * DM, (bf16_t*)(ws + WS_W_PG + l * SZ_W_SQ), DM, DM, r % I8, 0}; } else { r -= 2 * I8; \
            { const int l = r / I10; D = TItem{a.in[18] + (size_t)l * PLE * DM, (bf16_t*)(ws + WS_W_PP + l * SZ_W_PP), PLE, DM, r % I10, 0}; } } } } } } } } } while (0)
        { float tv[32]; TItem dn{};
          if (gw < NITEMS) { T_DECODE(dn, gw); t_load(dn, lane, tv); }
          for (int it = gw; it < NITEMS; it += ngw) {
              const TItem dc = dn;
              t_stage(lane, tv, scr);
              if (it + ngw < NITEMS) { T_DECODE(dn, it + ngw); t_load(dn, lane, tv); }
              t_store(dc, lane, scr);
          } }
#undef T_DECODE
        rowpass<true>(gw, ngw, lane, a.in[0], a.in[1], nullptr, nullptr, nullptr, nullptr, a.in[4], Abuf);
        { constexpr size_t NSTEP = (size_t)2 * TT * PLE / 8; const size_t stride = (size_t)G * NTHREADS;
          for (size_t i0 = (size_t)bid * NTHREADS + tid; i0 < NSTEP; i0 += 4 * stride) {
              f32x4 x0[4], x1[4];
#pragma unroll
              for (int q = 0; q < 4; ++q) { const size_t i = i0 + q * stride;
                  if (i < NSTEP) { const size_t e = i * 8, l = e / ((size_t)TT * PLE), rem = e % ((size_t)TT * PLE);
                      const float* src = (rem < (size_t)TP * PLE) ? a.in[2] + l * (size_t)TP * PLE + rem : a.in[3] + l * (size_t)TP * PLE + (rem - (size_t)TP * PLE);
                      x0[q] = *(const f32x4*)src; x1[q] = *(const f32x4*)(src + 4); } }
#pragma unroll
              for (int q = 0; q < 4; ++q) { const size_t i = i0 + q * stride;
                  if (i < NSTEP) { u32x4 w; w.x = pk2(x0[q][0], x0[q][1]); w.y = pk2(x0[q][2], x0[q][3]); w.z = pk2(x1[q][0], x1[q][1]); w.w = pk2(x1[q][2], x1[q][3]);
                      *(u32x4*)(PB + i * 8) = w; } }
          } }
        for (int i = bid * NTHREADS + tid; i < TT; i += G * NTHREADS) ((float*)(ws + WS_SS))[i] = 0.f;
        { const int gi = bid * NTHREADS + tid;
          if (gi < 8192) { const int pos = gi >> 5, f = gi & 31;
              const float inv_freq = __builtin_amdgcn_exp2f(-(float)f * (13.287712379549449f / 32.0f));
              const float ang = (float)pos * inv_freq;
              double rev = (double)ang * 0.15915494309189535; rev -= __builtin_rint(rev); const float revf = (float)rev;
              float* tp = (float*)(ws + WS_TAB) + gi * 2; tp[0] = __builtin_amdgcn_cosf(revf); tp[1] = __builtin_amdgcn_sinf(revf); } }
        if (((PROBE_REP >> 0) & 1) && rep_ == 0) xcd_barrier(bar); }
        SEAM(0);
    }
    if (IN(1)) { GEMM_STORE(Abuf, WPTR(WS_W_NAQKV), NAQKV, DM, QKV, NAQKV, 1024); SEAM(1); }
    if (IN(2)) { REP(2) { na_phase(lds, QKV, a.in[9], Obuf, bid, G); REPBAR(2); } SEAM(2); }
    if (IN(3)) { if ((PROBE_REP >> 3) & 1) { GEMM_STORE(Obuf, WPTR(WS_W_NAO), DM, DM, MB, DM, 0); xcd_barrier(bar); }
        GEMM_STORE(Obuf, WPTR(WS_W_NAO), DM, DM, MB, DM, 0); SEAM(3); }
    if (IN(4)) { REP(4) { rowpass<true>(gw, ngw, lane, a.in[0], a.in[1], nullptr, Hb, MB, a.in[5], a.in[6], Abuf); REPBAR(4); } SEAM(4); }
    if (IN(5)) { if ((PROBE_REP >> 5) & 1) { GEMM_SWIGLU(WPTR(WS_W_GU)); xcd_barrier(bar); }
        GEMM_SWIGLU(WPTR(WS_W_GU)); SEAM(5); }
    if (IN(6)) { GEMM_STORE(ACT, WPTR(WS_W_DN), DM, DFF, MB, DM, 0); GEMM_STORE(PB, WPTR(WS_W_PP), DM, PLE, PPb, DM, 0); SEAM(6); }
    if (IN(7)) { rowpass<false>(gw, ngw, lane, nullptr, nullptr, Hb, Hb, MB, a.in[7], nullptr, Abuf); SEAM(7); }
    if (IN(8)) { GEMM_GATE(WPTR(WS_W_PG), 2); SEAM(8); }
    if (IN(10)) { GEMM_STORE_RS((const bf16_t*)(ws + WS_A2), WPTR(WS_W_GQKV), GQKV, DM, QKV, GQKV, (const float*)(ws + WS_SS)); SEAM(10); }
    if (IN(11)) { qk_norm_rope(gw, ngw, lane, QKV, (bf16_t*)(ws + WS_KC), (bf16_t*)(ws + WS_VC), (const float*)(ws + WS_TAB), a.in[12], a.in[13]); SEAM(11); }
    if (IN(12)) {
        REP(12) {
        for (int k = bid; k < 1024; k += G) {
            int rowbase, kvbase, seq, h;
            if (k < 512) { h = k & 7; const int qb = k >> 3; rowbase = TP + qb * 256; kvbase = TP; seq = 16384; }
            else { const int k2 = k - 512, b = k2 & 7, s = k2 >> 3; h = s >> 3; const int qb = s & 7; rowbase = b * 2048 + qb * 256; kvbase = b * 2048; seq = 2048; }
            const att::bf16* Q = (const att::bf16*)QKV;
            att::attn_dense_body<att::bf16>(Q + (size_t)rowbase * GQKV + h * 128, (const att::bf16*)(ws + WS_KC) + ((size_t)(h >> 1) * TT + kvbase) * 128, (const att::bf16*)(ws + WS_VC) + ((size_t)(h >> 1) * TT + kvbase) * 128,
                                            (att::bf16*)Obuf + (size_t)rowbase * DM + h * 128, seq, (char*)lds_raw);
            __syncthreads();
        }
        REPBAR(12); }
        SEAM(12);
    }
    if (IN(13)) { GEMM_STORE(Obuf, WPTR(WS_W_GO), DM, DM, MB, DM, 0); SEAM(13); }
    if (IN(14)) { rowpass<false>(gw, ngw, lane, nullptr, nullptr, Hb, Hb, MB, a.in[5] + DM, a.in[6] + DM, Abuf); SEAM(14); }
    if (IN(15)) { GEMM_SWIGLU(WPTR(WS_W_GU + SZ_W_GU)); SEAM(15); }
    if (IN(16)) { GEMM_STORE(ACT, WPTR(WS_W_DN + SZ_W_DN), DM, DFF, MB, DM, 0); GEMM_STORE(PB + (size_t)TT * PLE, WPTR(WS_W_PP + SZ_W_PP), DM, PLE, PPb, DM, 0); SEAM(16); }
    if (IN(17)) { rowpass<false>(gw, ngw, lane, nullptr, nullptr, Hb, Hb, MB, a.in[7] + DM, nullptr, Abuf); SEAM(17); }
    if (IN(18)) { GEMM_GATE(WPTR(WS_W_PG + SZ_W_SQ), 1); }
#undef IN
#undef SEAM
}

extern "C" void kernel_launch(void* const* d_in, const int* in_sizes, int n_in, void* d_out, int out_size, void* d_ws, size_t ws_size, hipStream_t stream) {
    static int grid = 0;
    if (grid == 0) {
        if (n_in != 19 || out_size != TT * DM || ws_size < WS_END) { fprintf(stderr, "kernel_launch: unexpected shapes (n_in %d out %d ws %zu)\n", n_in, out_size, ws_size); grid = -1; return; }
        int dev = 0, cus = 0, per_cu = 0;
        if (hipGetDevice(&dev) != hipSuccess || hipDeviceGetAttribute(&cus, hipDeviceAttributeMultiprocessorCount, dev) != hipSuccess) { grid = -1; return; }
        if (hipFuncSetAttribute((const void*)mega_fwd, hipFuncAttributeMaxDynamicSharedMemorySize, LDS_BYTES) != hipSuccess) { fprintf(stderr, "kernel_launch: hipFuncSetAttribute failed\n"); grid = -1; return; }
        if (hipOccupancyMaxActiveBlocksPerMultiprocessor(&per_cu, (const void*)mega_fwd, NTHREADS, LDS_BYTES) != hipSuccess || per_cu < 1) { fprintf(stderr, "kernel_launch: occupancy query says %d\n", per_cu); per_cu = 1; }
        (void)hipGetLastError();
        grid = cus * 1;
        if (grid > 256) grid = 256;
    }
    if (grid < 0) return;
    if (hipMemsetAsync((char*)d_ws + WS_CTL, 0, 16384, stream) != hipSuccess) { fprintf(stderr, "kernel_launch: hipMemsetAsync failed\n"); return; }
    Args a{};
    for (int i = 0; i < 19; ++i) a.in[i] = (const float*)d_in[i];
    a.out = (float*)d_out; a.ws = (unsigned char*)d_ws;
#if MK_PER_PHASE
    for (int ph = 0; ph < N_PHASES; ++ph) {
        a.ph_lo = ph; a.ph_hi = ph + 1;
        hipLaunchKernelGGL(mega_fwd, dim3(grid), dim3(NTHREADS), LDS_BYTES, stream, a);
    }
#else
    a.ph_lo = 0; a.ph_hi = N_PHASES;
    void* args[] = {&a};
    hipError_t e = hipLaunchCooperativeKernel((const void*)mega_fwd, dim3(grid), dim3(NTHREADS), args, LDS_BYTES, stream);
    if (e != hipSuccess) fprintf(stderr, "kernel_launch: cooperative launch failed: %s (grid %d)\n", hipGetErrorString(e), grid);
#endif
    const hipError_t le = hipPeekAtLastError();
    if (le != hipSuccess) fprintf(stderr, "kernel_launch: launch failed: %s\n", hipGetErrorName(le));
}
```

```cpp
#include <hip/hip_runtime.h>
#include <hip/hip_cooperative_groups.h>
#include <hip/hip_bf16.h>
#include <cstdio>
#include <cstdint>
#include <cmath>
namespace cg = cooperative_groups;

#ifndef MK_PER_PHASE
#define MK_PER_PHASE 0
#endif
namespace pg8 {
#define PG8_LAS __attribute__((address_space(3)))
typedef unsigned short bf16_t;
typedef short bf16x8 __attribute__((ext_vector_type(8)));
typedef float f32x4 __attribute__((ext_vector_type(4)));
typedef unsigned u32x4 __attribute__((ext_vector_type(4)));
constexpr int BM = 256, BK = 64, HALF = 128, HTB = HALF * BK * 2  , STAGE_BYTES = 8 * HTB, NXCD = 8, WGM = 4;

__host__ __device__ __forceinline__ int lds_byte(int r, int c) { const int st = (r >> 4) * 2 + (c >> 5), rr = r & 15, cc = c & 31, ob = rr * 64 + cc * 2; return st * 1024 + (ob ^ (((ob >> 9) & 1) << 5)); }
__host__ __device__ __forceinline__ void stage_rc(int b, int& R, int& C) { const int st = b / 1024, sb = b % 1024, swz = sb ^ (((sb >> 9) & 1) << 5); R = (st >> 1) * 16 + swz / 64; C = (st & 1) * 32 + (swz % 64) / 2; }
__host__ __device__ __forceinline__ int perm32(int rho) { const int n = rho >> 4, i = rho & 15; return 8 * (i >> 2) + 4 * n + (i & 3); }

struct Unit { int pm, pn; };
struct Gemm { const bf16_t* A; const bf16_t* Bt; int M, N, K; };

struct StaticOrder {
    int nM, nN, nwg, G, c;
    __host__ __device__ void init(int M, int N, int G_, int c_) { nM = M / BM; nN = N / BM; nwg = nM * nN; G = G_; c = c_; }
    __host__ __device__ bool next(int i, Unit& u) const {
        const long L = (long)i * G + c; if (L >= nwg) return false;
        int wgid = (int)L; { const int q = nwg / NXCD, r = nwg % NXCD, xcd = wgid % NXCD, off = wgid / NXCD; wgid = (xcd < r ? xcd * (q + 1) : r * (q + 1) + (xcd - r) * q) + off; }
        const int nig = WGM * nN, gid = wgid / nig, fm = gid * WGM, gsz = (nM - fm) < WGM ? (nM - fm) : WGM;
        u.pm = fm + ((wgid % nig) % gsz); u.pn = (wgid % nig) / gsz; return true;
    }
    __device__ __forceinline__ void a_ready(const Unit&) const {}
    __device__ __forceinline__ void done(const Unit&) const {}
};

__device__ __forceinline__ unsigned cvt_pk_bf16(float lo, float hi) { unsigned r; asm volatile("v_cvt_pk_bf16_f32 %0, %1, %2" : "=v"(r) : "v"(lo), "v"(hi)); return r; }
typedef float f32x2 __attribute__((ext_vector_type(2)));
typedef unsigned u32x2 __attribute__((ext_vector_type(2)));
__device__ __forceinline__ float bf_lo(unsigned w) { return __uint_as_float(w << 16); }
__device__ __forceinline__ float bf_hi(unsigned w) { return __uint_as_float(w & 0xffff0000u); }
__device__ __forceinline__ float sigmoid_f(float x) { return __builtin_amdgcn_rcpf(1.0f + __builtin_amdgcn_exp2f(-1.4426950408889634f * x)); }

template <bool ROWSCALE> struct EpiStore {
    static constexpr bool PERM = true, AFTER_DRAIN = false;
    bf16_t* O; int ldc; int qcols; float qscale; const float* SS;
    __device__ __forceinline__ void operator()(const f32x4 (&acc)[2][2][4][2], const Unit& u, int wr, int wc, int fr, int fq) const {
        const int row0 = u.pm * BM + wr * 64 + fr; const int colt = u.pn * BM;
        const float sc0 = (colt < qcols) ? qscale : 1.f;
        const int col0 = colt + wc * 32 + 8 * fq;
#pragma unroll
        for (int ai = 0; ai < 2; ++ai)
#pragma unroll
            for (int m = 0; m < 4; ++m) { const int row = row0 + ai * HALF + m * 16; bf16_t* rowp = O + (size_t)row * ldc + col0;
                float sc = sc0; if (ROWSCALE) sc *= 1.0f / sqrtf(SS[row] * (1.0f / 1024.0f) + 1e-6f);
#pragma unroll
                for (int bj = 0; bj < 2; ++bj) { const f32x4 v0 = acc[ai][bj][m][0] * sc, v1 = acc[ai][bj][m][1] * sc;
                    u32x4 w; w.x = cvt_pk_bf16(v0[0], v0[1]); w.y = cvt_pk_bf16(v0[2], v0[3]); w.z = cvt_pk_bf16(v1[0], v1[1]); w.w = cvt_pk_bf16(v1[2], v1[3]);
                    *(u32x4*)(rowp + bj * HALF) = w; } }
    }
};
struct EpiSwiglu {
    static constexpr bool PERM = true, AFTER_DRAIN = false;
    bf16_t* O; int ldc;
    __device__ __forceinline__ void operator()(const f32x4 (&acc)[2][2][4][2], const Unit& u, int wr, int wc, int fr, int fq) const {
        const int row0 = u.pm * BM + wr * 64 + fr; const int col0 = u.pn * HALF + wc * 32 + 8 * fq;
#pragma unroll
        for (int ai = 0; ai < 2; ++ai)
#pragma unroll
            for (int m = 0; m < 4; ++m) { bf16_t* rowp = O + (size_t)(row0 + ai * HALF + m * 16) * ldc + col0;
                float r[8];
#pragma unroll
                for (int n = 0; n < 2; ++n)
#pragma unroll
                    for (int e = 0; e < 4; ++e) { const float g = acc[ai][0][m][n][e], up = acc[ai][1][m][n][e]; r[n * 4 + e] = g * sigmoid_f(g) * up; }
                u32x4 w; w.x = cvt_pk_bf16(r[0], r[1]); w.y = cvt_pk_bf16(r[2], r[3]); w.z = cvt_pk_bf16(r[4], r[5]); w.w = cvt_pk_bf16(r[6], r[7]);
                *(u32x4*)rowp = w; }
    }
};
template <int MODE> struct EpiGate {
    static constexpr bool PERM = true, AFTER_DRAIN = false;
    const bf16_t* Hin; const bf16_t* PP; bf16_t* Hout; float* Fout; bf16_t* A2; const float* gpre; float* SS;
    __device__ __forceinline__ void operator()(const f32x4 (&acc)[2][2][4][2], const Unit& u, int wr, int wc, int fr, int fq) const {
        const int row0 = u.pm * BM + wr * 64 + fr; const int col0 = u.pn * BM + wc * 32 + 8 * fq;
        float gp[2][8];
        if (MODE == 2) {
#pragma unroll
            for (int bj = 0; bj < 2; ++bj) { const f32x4 g0 = *(const f32x4*)(gpre + col0 + bj * HALF), g1 = *(const f32x4*)(gpre + col0 + bj * HALF + 4);
#pragma unroll
                for (int e = 0; e < 4; ++e) { gp[bj][e] = g0[e]; gp[bj][4 + e] = g1[e]; } }
        }
#pragma unroll
        for (int ai = 0; ai < 2; ++ai)
#pragma unroll
            for (int m = 0; m < 4; ++m) { const int row = row0 + ai * HALF + m * 16; const size_t off = (size_t)row * 1024 + col0; float rs = 0.f;
#pragma unroll
                for (int bj = 0; bj < 2; ++bj) { const size_t c = off + bj * HALF;
                    const u32x4 hw = *(const u32x4*)(Hin + c); const u32x4 pw = *(const u32x4*)(PP + c);
                    float o[8];
#pragma unroll
                    for (int n = 0; n < 2; ++n)
#pragma unroll
                        for (int w = 0; w < 2; ++w) { const unsigned hh = hw[2 * n + w], pp = pw[2 * n + w]; const f32x4 a = acc[ai][bj][m][n];
                            o[4 * n + 2 * w] = bf_lo(hh) + bf_lo(pp) * sigmoid_f(a[2 * w]); o[4 * n + 2 * w + 1] = bf_hi(hh) + bf_hi(pp) * sigmoid_f(a[2 * w + 1]); }
                    if (MODE == 1) { *(f32x4*)(Fout + c) = (f32x4){o[0], o[1], o[2], o[3]}; *(f32x4*)(Fout + c + 4) = (f32x4){o[4], o[5], o[6], o[7]}; }
                    else { u32x4 w; w.x = cvt_pk_bf16(o[0], o[1]); w.y = cvt_pk_bf16(o[2], o[3]); w.z = cvt_pk_bf16(o[4], o[5]); w.w = cvt_pk_bf16(o[6], o[7]); *(u32x4*)(Hout + c) = w; }
                    if (MODE == 2) {
#pragma unroll
                        for (int e = 0; e < 8; ++e) rs += o[e] * o[e];
                        u32x4 w; w.x = cvt_pk_bf16(o[0] * gp[bj][0], o[1] * gp[bj][1]); w.y = cvt_pk_bf16(o[2] * gp[bj][2], o[3] * gp[bj][3]);
                        w.z = cvt_pk_bf16(o[4] * gp[bj][4], o[5] * gp[bj][5]); w.w = cvt_pk_bf16(o[6] * gp[bj][6], o[7] * gp[bj][7]); *(u32x4*)(A2 + c) = w; } }
                if (MODE == 2) { rs += __shfl_xor(rs, 16); rs += __shfl_xor(rs, 32); if (fq == 0) atomicAdd(SS + row, rs); } }
    }
};
template <class Epi, class Sched, bool ALIGN_EPI = false, bool SP2 = false>
__device__ __forceinline__ void gemm_phase(PG8_LAS unsigned char* lds, const Gemm g, const Sched& S, const Epi& E) {
    const int tid = threadIdx.x, wid = __builtin_amdgcn_readfirstlane(tid >> 6), lane = tid & 63, wr = wid >> 2, wc = wid & 3, fr = lane & 15, fq = lane >> 4;
    const int K = g.K, nt = K / BK;
    unsigned voffA[2], voffB[2];
#pragma unroll
    for (int i = 0; i < 2; ++i) { int R, C; stage_rc(tid * 16 + i * 8192, R, C); const int Rb = Epi::PERM ? ((R & ~31) + perm32(R & 31)) : R;
        voffA[i] = (unsigned)(R * K + C) * 2u; voffB[i] = (unsigned)(Rb * K + C) * 2u; }
    const size_t kstep = (size_t)(BK * 2);
    const size_t hstep = (size_t)HALF * K * 2;
    const size_t tstep = 2 * hstep;
    const unsigned ldsw = (unsigned)wid * 1024u;
    const int aoff = lds_byte(wr * 64 + fr, fq * 8), boff = lds_byte(wc * 32 + fr, fq * 8);
#define PG8_SA(b, h) (((b) * 2 + (h)) * HTB)
#define PG8_SB(b, h) ((4 + (b) * 2 + (h)) * HTB)
#define PG8_STAGE(bufoff, gbase, voff) do { _Pragma("unroll") for (int _i = 0; _i < 2; ++_i) \
        __builtin_amdgcn_global_load_lds((const unsigned*)((const char*)(gbase) + (voff)[_i]), (PG8_LAS unsigned*)(lds + (bufoff) + ldsw + _i * 8192), 16, 0, 0); } while (0)
#define PG8_LDA(dst, b, h) do { _Pragma("unroll") for (int m = 0; m < 4; ++m) _Pragma("unroll") for (int k = 0; k < 2; ++k) dst[m][k] = *(const PG8_LAS bf16x8*)(lds + PG8_SA(b, h) + aoff + m * 2048 + k * 1024); } while (0)
#define PG8_LDB(dst, b, h) do { _Pragma("unroll") for (int n = 0; n < 2; ++n) _Pragma("unroll") for (int k = 0; k < 2; ++k) dst[n][k] = *(const PG8_LAS bf16x8*)(lds + PG8_SB(b, h) + boff + n * 2048 + k * 1024); } while (0)
#define PG8_MMA(ai, bj, At, Bt) do { __builtin_amdgcn_s_setprio(1); _Pragma("unroll") for (int m = 0; m < 4; ++m) _Pragma("unroll") for (int n = 0; n < 2; ++n) _Pragma("unroll") for (int k = 0; k < 2; ++k) \
        acc[ai][bj][m][n] = __builtin_amdgcn_mfma_f32_16x16x32_bf16(Bt[n][k], At[m][k], acc[ai][bj][m][n], 0, 0, 0); __builtin_amdgcn_s_setprio(0); } while (0)
#define PG8_WAIT_V(n) asm volatile("s_waitcnt vmcnt(" #n ")" ::: "memory")
#define PG8_WAIT_L(n) asm volatile("s_waitcnt lgkmcnt(" #n ")" ::: "memory")
#define PG8_BAR __builtin_amdgcn_s_barrier()
#define PG8_SCHED __builtin_amdgcn_sched_barrier(0)
    Unit cur, nxt; int ui = 0;
    if (!S.next(0, cur)) return;
    f32x4 acc[2][2][4][2];
#pragma unroll
    for (int a = 0; a < 2; ++a)
#pragma unroll
        for (int b = 0; b < 2; ++b)
#pragma unroll
            for (int m = 0; m < 4; ++m)
#pragma unroll
                for (int n = 0; n < 2; ++n) acc[a][b][m][n] = (f32x4){0.f, 0.f, 0.f, 0.f};
    bf16x8 At[4][2], B0[2][2], B1[2][2];
    const char* cA = (const char*)g.A + (size_t)cur.pm * tstep; const char* cB = (const char*)g.Bt + (size_t)cur.pn * tstep;
    S.a_ready(cur);
    if constexpr (SP2) {
        PG8_STAGE(PG8_SB(0, 0), cB, voffB); PG8_STAGE(PG8_SB(0, 1), cB + hstep, voffB); PG8_STAGE(PG8_SA(0, 0), cA, voffA); PG8_STAGE(PG8_SA(0, 1), cA + hstep, voffA);
        if (wr == 1) PG8_BAR;
        PG8_WAIT_V(2); PG8_BAR;
        PG8_STAGE(PG8_SB(1, 0), cB + kstep, voffB); PG8_STAGE(PG8_SA(1, 0), cA + kstep, voffA); PG8_STAGE(PG8_SB(1, 1), cB + hstep + kstep, voffB);
        PG8_WAIT_V(6); PG8_BAR;
    } else {
        PG8_STAGE(PG8_SB(0, 0), cB, voffB); PG8_STAGE(PG8_SA(0, 0), cA, voffA); PG8_STAGE(PG8_SB(0, 1), cB + hstep, voffB); PG8_STAGE(PG8_SA(0, 1), cA + hstep, voffA);
        if (wr == 1) PG8_BAR;
        PG8_WAIT_V(4); PG8_BAR;
        PG8_STAGE(PG8_SB(1, 0), cB + kstep, voffB); PG8_STAGE(PG8_SA(1, 0), cA + kstep, voffA); PG8_STAGE(PG8_SB(1, 1), cB + hstep + kstep, voffB);
        PG8_WAIT_V(6); PG8_BAR;
    }
    for (;;) {
        const bool has_next = S.next(ui + 1, nxt);
        const char* nA = has_next ? (const char*)g.A + (size_t)nxt.pm * tstep : cA; const char* nB = has_next ? (const char*)g.Bt + (size_t)nxt.pn * tstep : cB;
        for (int t = 0; t < nt; t += 2) {
            const bool last = (t == nt - 2);
            const char* a1 = cA + (size_t)(t + 1) * kstep;
            const char* a2 = last ? nA : cA + (size_t)(t + 2) * kstep; const char* b2 = last ? nB : cB + (size_t)(t + 2) * kstep;
            const char* a3 = a2 + kstep; const char* b3 = b2 + kstep;
            if (last && has_next) S.a_ready(nxt);
            if constexpr (SP2) {
            PG8_LDB(B0, 0, 0); PG8_LDB(B1, 0, 1); PG8_SCHED; PG8_LDA(At, 0, 0); PG8_STAGE(PG8_SA(1, 1), a1 + hstep, voffA);
            PG8_WAIT_V(8); PG8_WAIT_L(0); PG8_BAR; PG8_MMA(0, 0, At, B0); PG8_MMA(0, 1, At, B1); PG8_BAR; PG8_SCHED;
            PG8_LDA(At, 0, 1); PG8_STAGE(PG8_SB(0, 0), b2, voffB); PG8_STAGE(PG8_SB(0, 1), b2 + hstep, voffB); PG8_STAGE(PG8_SA(0, 0), a2, voffA);
            PG8_WAIT_V(8); PG8_WAIT_L(0); PG8_BAR; PG8_MMA(1, 0, At, B0); PG8_MMA(1, 1, At, B1); PG8_BAR; PG8_SCHED;
            PG8_LDB(B0, 1, 0); PG8_LDB(B1, 1, 1); PG8_SCHED; PG8_LDA(At, 1, 0); PG8_STAGE(PG8_SA(0, 1), a2 + hstep, voffA);
            PG8_WAIT_V(8); PG8_WAIT_L(0); PG8_BAR; PG8_MMA(0, 0, At, B0); PG8_MMA(0, 1, At, B1); PG8_BAR; PG8_SCHED;
            PG8_LDA(At, 1, 1); PG8_STAGE(PG8_SB(1, 0), b3, voffB); PG8_STAGE(PG8_SB(1, 1), b3 + hstep, voffB); PG8_STAGE(PG8_SA(1, 0), a3, voffA);
            PG8_WAIT_V(8); PG8_WAIT_L(0); PG8_BAR; PG8_MMA(1, 0, At, B0); PG8_MMA(1, 1, At, B1); PG8_BAR; PG8_SCHED;
            } else {
            PG8_LDB(B0, 0, 0); PG8_SCHED; PG8_LDA(At, 0, 0); PG8_STAGE(PG8_SA(1, 1), a1 + hstep, voffA);
            PG8_WAIT_L(8); PG8_BAR; PG8_WAIT_L(0); PG8_MMA(0, 0, At, B0); PG8_BAR; PG8_SCHED;
            PG8_LDB(B1, 0, 1); PG8_STAGE(PG8_SB(0, 0), b2, voffB);
            PG8_BAR; PG8_WAIT_L(0); PG8_MMA(0, 1, At, B1); PG8_BAR;
            PG8_LDA(At, 0, 1); PG8_STAGE(PG8_SA(0, 0), a2, voffA);
            PG8_BAR; PG8_WAIT_L(0); PG8_MMA(1, 0, At, B0); PG8_BAR; PG8_SCHED;
            PG8_STAGE(PG8_SB(0, 1), b2 + hstep, voffB);
            PG8_WAIT_V(6); PG8_BAR; PG8_MMA(1, 1, At, B1); PG8_BAR;
            PG8_LDB(B0, 1, 0); PG8_SCHED; PG8_LDA(At, 1, 0); PG8_STAGE(PG8_SA(0, 1), a2 + hstep, voffA);
            PG8_WAIT_L(8); PG8_BAR; PG8_WAIT_L(0); PG8_MMA(0, 0, At, B0); PG8_BAR; PG8_SCHED;
            PG8_LDB(B1, 1, 1); PG8_STAGE(PG8_SB(1, 0), b3, voffB);
            PG8_BAR; PG8_WAIT_L(0); PG8_MMA(0, 1, At, B1); PG8_BAR;
            PG8_LDA(At, 1, 1); PG8_STAGE(PG8_SA(1, 0), a3, voffA);
            PG8_BAR; PG8_WAIT_L(0); PG8_MMA(1, 0, At, B0); PG8_BAR; PG8_SCHED;
            PG8_STAGE(PG8_SB(1, 1), b3 + hstep, voffB);
            PG8_WAIT_V(6); PG8_BAR; PG8_MMA(1, 1, At, B1); PG8_BAR;
            }
        }
        if constexpr (ALIGN_EPI) { if (wr == 0) PG8_BAR; }
        if constexpr (!Epi::AFTER_DRAIN) { E(acc, cur, wr, wc, fr, fq); S.done(cur); }
        if (!has_next) break;
#pragma unroll
        for (int a = 0; a < 2; ++a)
#pragma unroll
            for (int b = 0; b < 2; ++b)
#pragma unroll
                for (int m = 0; m < 4; ++m)
#pragma unroll
                    for (int n = 0; n < 2; ++n) acc[a][b][m][n] = (f32x4){0.f, 0.f, 0.f, 0.f};
        cur = nxt; cA = nA; cB = nB; ++ui;
        if constexpr (ALIGN_EPI) { if (wr == 1) PG8_BAR; }
    }
    PG8_WAIT_V(0);
    if constexpr (!ALIGN_EPI) { if (wr == 0) PG8_BAR; }
    PG8_BAR;
    if constexpr (Epi::AFTER_DRAIN) { E.fused(acc, cur, wr, wc, fr, fq, lds, wid, lane); S.done(cur); }
#undef PG8_SA
#undef PG8_SB
#undef PG8_STAGE
#undef PG8_LDA
#undef PG8_LDB
#undef PG8_MMA
#undef PG8_WAIT_V
#undef PG8_WAIT_L
#undef PG8_BAR
#undef PG8_SCHED
}
}
namespace att {
using bf16 = __hip_bfloat16;
constexpr int   D = 128, NW = 8, QBLK = 32, KVBLK = 64;
constexpr float SCALE = 0.088388347648318440f;
constexpr float THR = 8.f;
constexpr int SDEPTH = 1;
constexpr int LDQ = 2048, LDK = 128, LDO = 1024;
constexpr size_t SHM_V = KVBLK * D * 2, SHM_K = KVBLK * D * 2, SHM_ATTN = 3 * SHM_V + 3 * SHM_K + NW * 64 * 4;
using bf16x8 = __attribute__((ext_vector_type(8))) short;
using s16x4  = __attribute__((ext_vector_type(4))) short;
using f32x16 = __attribute__((ext_vector_type(16))) float;
using f32x8  = __attribute__((ext_vector_type(8))) float;
using u32x4  = __attribute__((ext_vector_type(4))) unsigned;
#define KSWZ(row, colB) ((row) * 256 + ((colB) ^ (((row) & 7) << 4)))
#define SBAR() __builtin_amdgcn_sched_barrier(0)
__device__ __forceinline__ int crow(int r, int hi) { return (r & 3) + 8 * (r >> 2) + 4 * hi; }
__device__ __forceinline__ unsigned cvtpk(float lo, float hi) {
  unsigned r; asm volatile("v_cvt_pk_bf16_f32 %0, %1, %2" : "=v"(r) : "v"(lo), "v"(hi)); return r;
}
template <typename TIn> struct Stage;
template <> struct Stage<bf16>  { using T = bf16x8;
  __device__ static __forceinline__ T ld8(const bf16* p) { return *reinterpret_cast<const bf16x8*>(p); }
  __device__ static __forceinline__ bf16x8 tobf(T x) { return x; } };
template <> struct Stage<float> { using T = f32x8;
  __device__ static __forceinline__ T ld8(const float* p) { return *reinterpret_cast<const f32x8*>(p); }
  __device__ static __forceinline__ bf16x8 tobf(T x) {
    u32x4 w = {cvtpk(x[0], x[1]), cvtpk(x[2], x[3]), cvtpk(x[4], x[5]), cvtpk(x[6], x[7])}; return *reinterpret_cast<bf16x8*>(&w); } };

__device__ __forceinline__ float rowmax32(const f32x16& p0, const f32x16& p1) {
  float pmax = p0[0]; for (int r = 1; r < 16; ++r) pmax = fmaxf(pmax, p0[r]); for (int r = 0; r < 16; ++r) pmax = fmaxf(pmax, p1[r]);
  auto rr = __builtin_amdgcn_permlane32_swap(__float_as_uint(pmax), __float_as_uint(pmax), false, false);
  return fmaxf(__uint_as_float(rr[0]), __uint_as_float(rr[1]));
}
__device__ __forceinline__ void partialSM_first(f32x16& p0, f32x16& p1, float& m_reg) {
  const float pmax = rowmax32(p0, p1); m_reg = pmax;
  for (int r = 0; r < 16; ++r) p0[r] -= pmax; for (int r = 0; r < 16; ++r) p1[r] -= pmax;
  for (int r = 0; r < 16; ++r) p0[r] = __builtin_amdgcn_exp2f(p0[r]);
}
__device__ __forceinline__ void partialSM_fix(f32x16& p0) { for (int r = 0; r < 16; ++r) p0[r] = __builtin_amdgcn_exp2f(p0[r]); }
__device__ __forceinline__ void partialSM(f32x16& p0, f32x16& p1, float& m_reg, float& alpha) {
  constexpr float THRL = THR * 1.4426950408889634f;
  const float pmax = rowmax32(p0, p1);
  if (__builtin_expect(__all(pmax <= THRL), 1)) { alpha = 1.f; }
  else { const float dl = fmaxf(pmax, 0.f); m_reg += dl; alpha = __builtin_amdgcn_exp2f(-dl);
    for (int r = 0; r < 16; ++r) p0[r] -= dl; for (int r = 0; r < 16; ++r) p1[r] -= dl; }
  for (int r = 0; r < 16; ++r) p0[r] = __builtin_amdgcn_exp2f(p0[r]);
}
__device__ __forceinline__ void finishSM(f32x16& p0, f32x16& p1, float alpha, float& l_reg, bf16x8& pa0, bf16x8& pa1, bf16x8& pa2, bf16x8& pa3) {
  for (int r = 0; r < 16; ++r) p1[r] = __builtin_amdgcn_exp2f(p1[r]);
  float ps = 0; for (int r = 0; r < 16; ++r) ps += p0[r]; for (int r = 0; r < 16; ++r) ps += p1[r];
  { auto rr = __builtin_amdgcn_permlane32_swap(__float_as_uint(ps), __float_as_uint(ps), false, false);
    ps = __uint_as_float(rr[0]) + __uint_as_float(rr[1]); }
  l_reg = l_reg * alpha + ps;
#define PK4(P, BASE, OUT) do { unsigned a0 = cvtpk(P[BASE + 0], P[BASE + 1]), a1 = cvtpk(P[BASE + 2], P[BASE + 3]);   \
    unsigned b0 = cvtpk(P[BASE + 4], P[BASE + 5]), b1 = cvtpk(P[BASE + 6], P[BASE + 7]);                              \
    auto r0 = __builtin_amdgcn_permlane32_swap(a0, b0, false, false); auto r1 = __builtin_amdgcn_permlane32_swap(a1, b1, false, false); \
    u32x4 w = {r0[0], r1[0], r0[1], r1[1]}; OUT = *reinterpret_cast<bf16x8*>(&w); } while (0)
  PK4(p0, 0, pa0); PK4(p0, 8, pa1); PK4(p1, 0, pa2); PK4(p1, 8, pa3);
#undef PK4
}
__device__ __forceinline__ void qkt(f32x16& p0, f32x16& p1, const bf16* Ks, const bf16x8* qr, int r32, int hi) {
  p0 = f32x16{}; p1 = f32x16{};
  for (int d0 = 0; d0 < 8; ++d0) { int cb = (d0 * 16 + hi * 8) * 2;
    bf16x8 b0 = *reinterpret_cast<const bf16x8*>((const char*)Ks + KSWZ(r32, cb));
    bf16x8 b1 = *reinterpret_cast<const bf16x8*>((const char*)Ks + KSWZ(32 + r32, cb));
    p0 = __builtin_amdgcn_mfma_f32_32x32x16_bf16(b0, qr[d0], p0, 0, 0, 0);
    p1 = __builtin_amdgcn_mfma_f32_32x32x16_bf16(b1, qr[d0], p1, 0, 0, 0); }
}
__device__ __forceinline__ int v_st(int k, int c) { const int kk = (k & ~0xC) | ((k & 4) << 1) | ((k & 8) >> 1); return ((kk >> 3) * 4 + (c >> 5)) * 512 + ((kk & 7) * 32 + (c & 31)) * 2; }
__device__ __forceinline__ int v_rd_base(int lane) { return ((lane & 3) << 3) | (((lane >> 2) & 3) << 6) | (((lane >> 4) & 1) << 5) | (((lane >> 5) & 1) << 8); }
constexpr int v_rd_off(int d0, int ks, int half) { return d0 * 512 + ks * 4096 + half * 2048; }
template <int OFF> __device__ __forceinline__ s16x4 tr_read(int vb) {
  s16x4 r; asm volatile("ds_read_b64_tr_b16 %0, %1 offset:%2" : "=&v"(r) : "v"(vb), "i"(OFF) : "memory"); return r;
}
template <int D0> __device__ __forceinline__ void pv_one(f32x16& od, int vb, bf16x8 pa0, bf16x8 pa1, bf16x8 pa2, bf16x8 pa3) {
  const s16x4 l0 = tr_read<v_rd_off(D0, 0, 0)>(vb), h0 = tr_read<v_rd_off(D0, 0, 1)>(vb), l1 = tr_read<v_rd_off(D0, 1, 0)>(vb), h1 = tr_read<v_rd_off(D0, 1, 1)>(vb);
  const s16x4 l2 = tr_read<v_rd_off(D0, 2, 0)>(vb), h2 = tr_read<v_rd_off(D0, 2, 1)>(vb), l3 = tr_read<v_rd_off(D0, 3, 0)>(vb), h3 = tr_read<v_rd_off(D0, 3, 1)>(vb);
  asm volatile("s_waitcnt lgkmcnt(0)" ::: "memory"); SBAR();
#define PK(L, H) (bf16x8){L[0], L[1], L[2], L[3], H[0], H[1], H[2], H[3]}
  od = __builtin_amdgcn_mfma_f32_32x32x16_bf16(pa0, PK(l0, h0), od, 0, 0, 0);
  od = __builtin_amdgcn_mfma_f32_32x32x16_bf16(pa1, PK(l1, h1), od, 0, 0, 0);
  od = __builtin_amdgcn_mfma_f32_32x32x16_bf16(pa2, PK(l2, h2), od, 0, 0, 0);
  od = __builtin_amdgcn_mfma_f32_32x32x16_bf16(pa3, PK(l3, h3), od, 0, 0, 0);
#undef PK
}
__device__ __forceinline__ void pv_d0(f32x16* o, int vb, bf16x8 pa0, bf16x8 pa1, bf16x8 pa2, bf16x8 pa3) {
  pv_one<0>(o[0], vb, pa0, pa1, pa2, pa3); pv_one<1>(o[1], vb, pa0, pa1, pa2, pa3); pv_one<2>(o[2], vb, pa0, pa1, pa2, pa3); pv_one<3>(o[3], vb, pa0, pa1, pa2, pa3);
}
template <typename TQ>
__device__ __forceinline__ void attn_dense_body(const TQ* __restrict__ Qb, const bf16* __restrict__ Kh, const bf16* __restrict__ Vh,
                                                bf16* __restrict__ Ob, int seq, char* lds) {
  using St = Stage<bf16>; using SQ = Stage<TQ>;
  const int tid = threadIdx.x, wid = tid >> 6, lane = tid & 63, r32 = lane & 31, hi = lane >> 5;
  bf16* V_lds = (bf16*)lds; bf16* K_lds = (bf16*)(lds + 3 * SHM_V);
  float* ws = (float*)(lds + 3 * SHM_V + 3 * SHM_K) + wid * 64; float* li_l = ws;
    float l_reg = 0; f32x16 o[4] = {}; bf16x8 qr[8];
  const TQ* Qw = Qb + (long)(wid * QBLK + r32) * LDQ + hi * 8;
#pragma unroll
  for (int d0 = 0; d0 < 8; ++d0) qr[d0] = SQ::tobf(SQ::ld8(Qw + d0 * 16));
  const int sr = tid >> 4, sc = (tid & 15) * 8, vst0 = v_st(sr, sc), vst1 = v_st(32 + sr, sc);
  const int vb0 = (int)(uintptr_t)V_lds + v_rd_base(lane);
  struct { typename St::T vs0, vs1, ks0, ks1; } sr_[SDEPTH];
#define SLOAD(i, k0) do { sr_[i].vs0 = St::ld8(&Vh[(long)((k0) + sr) * LDK + sc]); sr_[i].vs1 = St::ld8(&Vh[(long)((k0) + 32 + sr) * LDK + sc]); \
    sr_[i].ks0 = St::ld8(&Kh[(long)((k0) + sr) * LDK + sc]); sr_[i].ks1 = St::ld8(&Kh[(long)((k0) + 32 + sr) * LDK + sc]); } while (0)
#define SWRITE(b, i) do { *(bf16x8*)((char*)V_lds + (b) * SHM_V + vst0) = St::tobf(sr_[i].vs0);          \
    *(bf16x8*)((char*)V_lds + (b) * SHM_V + vst1) = St::tobf(sr_[i].vs1); int kc = sc * 2;               \
    *(bf16x8*)((char*)K_lds + (b) * SHM_K + KSWZ(sr, kc)) = St::tobf(sr_[i].ks0);                       \
    *(bf16x8*)((char*)K_lds + (b) * SHM_K + KSWZ(32 + sr, kc)) = St::tobf(sr_[i].ks1); } while (0)
#define SWAIT() do { if constexpr (SDEPTH == 2) asm volatile("s_waitcnt vmcnt(4)" ::: "memory"); else asm volatile("s_waitcnt vmcnt(0)" ::: "memory"); } while (0)
  f32x16 pA0, pA1, pB0, pB1; constexpr float alA = 1.f, alB = 1.f; bf16x8 pa0, pa1, pa2, pa3; const int NT = seq / KVBLK;
  constexpr int SE = 0, SO = 0;
  SLOAD(SE, 0); asm volatile("s_waitcnt vmcnt(0)" ::: "memory"); SWRITE(0, SE);
  SLOAD(SO, KVBLK);
  __syncthreads();
  qkt(pA0, pA1, K_lds, qr, r32, hi); partialSM_fix(pA0);
  SWAIT(); SWRITE(1, SO); SLOAD(SE, 2 * KVBLK);
  __syncthreads();
  int prev = 0, cur = 1, next = 2;
  for (int j = 1; j + 1 < NT; j += 2) {
    SBAR(); qkt(pB0, pB1, (bf16*)((char*)K_lds + cur * (int)SHM_K), qr, r32, hi);
    finishSM(pA0, pA1, alA, l_reg, pa0, pa1, pa2, pa3); SBAR();
    SWAIT(); SWRITE(next, SE);
    if (j + 2 < NT) SLOAD(SO, (j + 2) * KVBLK); SBAR();
    pv_d0(o, vb0 + prev * (int)SHM_V, pa0, pa1, pa2, pa3); partialSM_fix(pB0);
    __syncthreads();
    { const int t_ = prev; prev = cur; cur = next; next = t_; }
    SBAR(); qkt(pA0, pA1, (bf16*)((char*)K_lds + cur * (int)SHM_K), qr, r32, hi);
    finishSM(pB0, pB1, alB, l_reg, pa0, pa1, pa2, pa3); SBAR();
    if (j + 2 < NT) { SWAIT(); SWRITE(next, SO); }
    if (j + 3 < NT) SLOAD(SE, (j + 3) * KVBLK); SBAR();
    pv_d0(o, vb0 + prev * (int)SHM_V, pa0, pa1, pa2, pa3); partialSM_fix(pA0);
    __syncthreads();
    { const int t_ = prev; prev = cur; cur = next; next = t_; }
  }
  SBAR(); qkt(pB0, pB1, (bf16*)((char*)K_lds + cur * (int)SHM_K), qr, r32, hi);
  finishSM(pA0, pA1, alA, l_reg, pa0, pa1, pa2, pa3); SBAR();
  pv_d0(o, vb0 + prev * (int)SHM_V, pa0, pa1, pa2, pa3); partialSM_fix(pB0);
  finishSM(pB0, pB1, alB, l_reg, pa0, pa1, pa2, pa3); SBAR();
  pv_d0(o, vb0 + cur * (int)SHM_V, pa0, pa1, pa2, pa3);
  if (hi == 0) li_l[r32] = l_reg; asm volatile("s_waitcnt lgkmcnt(0)" ::: "memory");
  float rli[16];
#pragma unroll
  for (int r = 0; r < 16; ++r) rli[r] = __builtin_amdgcn_rcpf(li_l[crow(r, hi)]);
  bf16* Ow = Ob + (long)(wid * QBLK) * LDO;
#pragma unroll
  for (int r = 0; r < 16; ++r) { int orow = crow(r, hi);
    for (int d0 = 0; d0 < 4; ++d0) Ow[(long)orow * LDO + d0 * 32 + r32] = __float2bfloat16(o[d0][r] * rli[r]); }
#undef SLOAD
#undef SWRITE
#undef SWAIT
}
}
#define LAS __attribute__((address_space(3)))
typedef unsigned short bf16_t;
typedef float f32x4 __attribute__((ext_vector_type(4)));
typedef short bf16x8 __attribute__((ext_vector_type(8)));
typedef short s16x4 __attribute__((ext_vector_type(4)));
typedef unsigned u32x4 __attribute__((ext_vector_type(4)));
typedef unsigned u32x2 __attribute__((ext_vector_type(2)));
constexpr int DM = 1024, TP = 16384, TT = 32768, DFF = 2816, PLE = 256, NAQKV = 3072, GQKV = 2048;
constexpr int NTHREADS = 512, NWAVES = 8;
constexpr float RMS_EPS = 1e-6f;
constexpr int N_PHASES = 19;

constexpr size_t SZ_W_NAQKV = (size_t)NAQKV * DM * 2, SZ_W_SQ = (size_t)DM * DM * 2, SZ_W_GQKV = (size_t)GQKV * DM * 2, SZ_W_GU = (size_t)2 * DFF * DM * 2,
                 SZ_W_DN = (size_t)DM * DFF * 2, SZ_W_PP = (size_t)DM * PLE * 2;
constexpr size_t WS_W_NAQKV = 0, WS_W_NAO = WS_W_NAQKV + SZ_W_NAQKV, WS_W_GQKV = WS_W_NAO + SZ_W_SQ, WS_W_GO = WS_W_GQKV + SZ_W_GQKV,
                 WS_W_GU = WS_W_GO + SZ_W_SQ  , WS_W_DN = WS_W_GU + 2 * SZ_W_GU  , WS_W_PG = WS_W_DN + 2 * SZ_W_DN  ,
                 WS_W_PP = WS_W_PG + 2 * SZ_W_SQ  , WS_W_END = WS_W_PP + 2 * SZ_W_PP;
constexpr size_t MiB = 1u << 20;
static_assert(WS_W_END <= 56 * MiB, "weights region");
constexpr size_t WS_A = 56 * MiB;
constexpr size_t WS_QKV = WS_A + 64 * MiB;
constexpr size_t WS_O = WS_QKV + 192 * MiB;
constexpr size_t WS_MB = WS_O + 64 * MiB;
constexpr size_t WS_PB = WS_MB + 64 * MiB;
constexpr size_t WS_CTL = WS_PB + 32 * MiB;
constexpr size_t WS_TAB = WS_CTL + 65536;
constexpr size_t WS_SS = WS_CTL + 131072;
constexpr size_t WS_A2 = WS_QKV + 128 * MiB;
constexpr size_t WS_KC = WS_QKV + 128 * MiB, WS_VC = WS_KC + 32 * MiB;
constexpr size_t WS_END = WS_CTL + 1 * MiB;
constexpr int MISC_OFF = 131072 + 256;
constexpr int LDS_BYTES = 135168;

__device__ __forceinline__ float wave_sum(float v) {
#pragma unroll
    for (int o = 1; o < 64; o <<= 1) v += __shfl_xor(v, o);
    return v;
}
__device__ __forceinline__ unsigned f2bf(float f) { unsigned u = __builtin_bit_cast(unsigned, f); return (u + 0x7fffu + ((u >> 16) & 1u)) >> 16; }
__device__ __forceinline__ unsigned pk2(float lo, float hi) { unsigned r; asm volatile("v_cvt_pk_bf16_f32 %0, %1, %2" : "=v"(r) : "v"(lo), "v"(hi)); return r; }
__device__ __forceinline__ float bflo(unsigned w) { return __uint_as_float(w << 16); }
__device__ __forceinline__ float bfhi(unsigned w) { return __uint_as_float(w & 0xffff0000u); }

struct TItem { const float* W; bf16_t* WT; int K, N, item, perm; };
__device__ __forceinline__ void t_load(const TItem& d, int lane, float (&v)[32]) {
    const int nblk = d.N / 32, kb = d.item / nblk, nb = d.item % nblk, k0 = 64 * kb, n0 = 32 * nb;
    int s0 = n0;
    if (d.perm) { const int pn = n0 >> 8, rem = n0 & 255; s0 = (rem >> 7) * DFF + pn * 128 + (rem & 127); }
    const float* p = d.W + (size_t)(k0 + (lane >> 5)) * d.N + s0 + (lane & 31);
#pragma unroll
    for (int i = 0; i < 32; ++i) v[i] = p[(size_t)(2 * i) * d.N];
}
__device__ __forceinline__ void t_stage(int lane, const float (&v)[32], LAS float* scr) {
#pragma unroll
    for (int i = 0; i < 32; ++i) scr[(2 * i + (lane >> 5)) * 33 + (lane & 31)] = v[i];
    asm volatile("s_waitcnt lgkmcnt(0)" ::: "memory");
}
__device__ __forceinline__ void t_store(const TItem& d, int lane, LAS float* scr) {
    const int nblk = d.N / 32, kb = d.item / nblk, nb = d.item % nblk, k0 = 64 * kb, n0 = 32 * nb;
    const int c = lane & 7;
#pragma unroll
    for (int j = 0; j < 4; ++j) { const int n = (lane >> 3) + 8 * j; const LAS float* s = scr + (8 * c) * 33 + n;
        u32x4 o; o.x = pk2(s[0 * 33], s[1 * 33]); o.y = pk2(s[2 * 33], s[3 * 33]); o.z = pk2(s[4 * 33], s[5 * 33]); o.w = pk2(s[6 * 33], s[7 * 33]);
        *(u32x4*)(d.WT + (size_t)(n0 + n) * d.K + k0 + 8 * c) = o; }
    asm volatile("s_waitcnt lgkmcnt(0)" ::: "memory");
}

template <bool HIN_F32>
__device__ __forceinline__ void rp_load(int row, int lane, const float* hin0, const float* hin1, const bf16_t* Hin, const bf16_t* MB, float (&h)[2][8], u32x4 (&mw)[2]) {
    if (HIN_F32) {
        const float* hr = (row < TP) ? hin0 + (size_t)row * DM : hin1 + (size_t)(row - TP) * DM;
#pragma unroll
        for (int j = 0; j < 2; ++j) { const f32x4 a = *(const f32x4*)(hr + 8 * lane + 512 * j), b = *(const f32x4*)(hr + 8 * lane + 512 * j + 4);
#pragma unroll
            for (int e2 = 0; e2 < 4; ++e2) { h[j][e2] = a[e2]; h[j][4 + e2] = b[e2]; } }
    } else {
#pragma unroll
        for (int j = 0; j < 2; ++j) { const u32x4 w = *(const u32x4*)(Hin + (size_t)row * DM + 8 * lane + 512 * j);
#pragma unroll
            for (int e2 = 0; e2 < 4; ++e2) { h[j][2 * e2] = bflo(w[e2]); h[j][2 * e2 + 1] = bfhi(w[e2]); } }
    }
    if (MB) {
#pragma unroll
        for (int j = 0; j < 2; ++j) mw[j] = *(const u32x4*)(MB + (size_t)row * DM + 8 * lane + 512 * j);
    }
}
__device__ __forceinline__ void rp_finish(int row, int lane, float (&h)[2][8], const u32x4 (&mw)[2], bf16_t* Hout, bool hasM, const float* gpost, const float* gpre, bf16_t* Aout) {
    if (hasM) {
        float m[2][8]; float ss = 0.f;
#pragma unroll
        for (int j = 0; j < 2; ++j)
#pragma unroll
            for (int e2 = 0; e2 < 4; ++e2) { const float lo = bflo(mw[j][e2]), hi = bfhi(mw[j][e2]); m[j][2 * e2] = lo; m[j][2 * e2 + 1] = hi; ss += lo * lo + hi * hi; }
        const float r = 1.0f / sqrtf(wave_sum(ss) * (1.0f / DM) + RMS_EPS);
#pragma unroll
        for (int j = 0; j < 2; ++j) { const f32x4 g0 = *(const f32x4*)(gpost + 8 * lane + 512 * j), g1 = *(const f32x4*)(gpost + 8 * lane + 512 * j + 4);
#pragma unroll
            for (int e2 = 0; e2 < 4; ++e2) { h[j][e2] += m[j][e2] * r * g0[e2]; h[j][4 + e2] += m[j][4 + e2] * r * g1[e2]; }
            u32x4 w; w.x = pk2(h[j][0], h[j][1]); w.y = pk2(h[j][2], h[j][3]); w.z = pk2(h[j][4], h[j][5]); w.w = pk2(h[j][6], h[j][7]);
            *(u32x4*)(Hout + (size_t)row * DM + 8 * lane + 512 * j) = w; }
    }
    float s2 = 0.f;
#pragma unroll
    for (int j = 0; j < 2; ++j)
#pragma unroll
        for (int e2 = 0; e2 < 8; ++e2) s2 += h[j][e2] * h[j][e2];
    const float r2 = 1.0f / sqrtf(wave_sum(s2) * (1.0f / DM) + RMS_EPS);
#pragma unroll
    for (int j = 0; j < 2; ++j) { float o[8];
#pragma unroll
        for (int e2 = 0; e2 < 8; ++e2) o[e2] = h[j][e2] * r2;
        if (gpre) { const f32x4 g0 = *(const f32x4*)(gpre + 8 * lane + 512 * j), g1 = *(const f32x4*)(gpre + 8 * lane + 512 * j + 4);
#pragma unroll
            for (int e2 = 0; e2 < 4; ++e2) { o[e2] *= g0[e2]; o[4 + e2] *= g1[e2]; } }
        u32x4 w; w.x = pk2(o[0], o[1]); w.y = pk2(o[2], o[3]); w.z = pk2(o[4], o[5]); w.w = pk2(o[6], o[7]);
        *(u32x4*)(Aout + (size_t)row * DM + 8 * lane + 512 * j) = w; }
}
template <bool HIN_F32>
__device__ __forceinline__ void rowpass(int gw, int ngw, int lane, const float* hin0, const float* hin1, const bf16_t* Hin, bf16_t* Hout, const bf16_t* MB, const float* gpost, const float* gpre, bf16_t* Aout) {
    constexpr int NR = 4;
    for (int row = gw; row < TT; row += NR * ngw) {
        float hh[NR][2][8]; u32x4 mm[NR][2];
#pragma unroll
        for (int q = 0; q < NR; ++q) if (row + q * ngw < TT) rp_load<HIN_F32>(row + q * ngw, lane, hin0, hin1, Hin, MB, hh[q], mm[q]);
#pragma unroll
        for (int q = 0; q < NR; ++q) if (row + q * ngw < TT) rp_finish(row + q * ngw, lane, hh[q], mm[q], Hout, MB != nullptr, gpost, gpre, Aout);
    }
}

__device__ __forceinline__ void qk_norm_rope(int gw, int ngw, int lane, bf16_t* QKV, bf16_t* Kc, bf16_t* Vc, const float* tab, const float* qn, const float* kn) {
    const int hh = lane >> 2, c4 = lane & 3;
    const float qsc = (hh < 8) ? 0.12751743082459868f : 1.0f;
    float g[4][8];
    { const float* gsrc = (hh < 8) ? qn : kn;
#pragma unroll
      for (int ch = 0; ch < 4; ++ch) { const f32x4 g0 = *(const f32x4*)(gsrc + ch * 32 + c4 * 8), g1 = *(const f32x4*)(gsrc + ch * 32 + c4 * 8 + 4);
#pragma unroll
          for (int e2 = 0; e2 < 4; ++e2) { g[ch][e2] = g0[e2]; g[ch][4 + e2] = g1[e2]; } } }
    constexpr int NR = 4;
    for (int t0 = gw; t0 < TT; t0 += NR * ngw) {
        u32x4 xx[NR][4];
#pragma unroll
        for (int q = 0; q < NR; ++q) { const int t = t0 + q * ngw;
            if (t < TT) { const bf16_t* src = QKV + (size_t)t * GQKV + hh * 128 + c4 * 8;
#pragma unroll
                for (int ch = 0; ch < 4; ++ch) xx[q][ch] = *(const u32x4*)(src + ch * 32); } }
#pragma unroll
        for (int q = 0; q < NR; ++q) { const int t = t0 + q * ngw;
          if (t < TT) {
            const int tin = (t < TP) ? (t & 2047) : (t - TP);
            const int prow = tin >> 6, pcol = tin & 63;
            if (hh >= 12) {
                bf16_t* dst = Vc + ((size_t)(hh - 12) * TT + t) * 128 + c4 * 8;
#pragma unroll
                for (int ch = 0; ch < 4; ++ch) *(u32x4*)(dst + ch * 32) = xx[q][ch];
            } else {
                float v[4][8]; float ss = 0.f;
#pragma unroll
                for (int ch = 0; ch < 4; ++ch)
#pragma unroll
                    for (int w = 0; w < 4; ++w) { const float lo = bflo(xx[q][ch][w]), hi = bfhi(xx[q][ch][w]); v[ch][2 * w] = lo; v[ch][2 * w + 1] = hi; ss += lo * lo + hi * hi; }
                ss += __shfl_xor(ss, 1); ss += __shfl_xor(ss, 2);
                const float r = qsc / sqrtf(ss * (1.0f / 128.0f) + RMS_EPS);
                u32x4 y[4];
#pragma unroll
                for (int ax = 0; ax < 2; ++ax) {
                    const f32x4* tp = (const f32x4*)(tab + ((ax ? pcol : prow) * 32 + c4 * 8) * 2);
                    u32x4 oa, ob;
#pragma unroll
                    for (int w = 0; w < 4; ++w) {
                        const f32x4 cs2 = tp[w];
                        const float a0 = v[2 * ax][2 * w] * r * g[2 * ax][2 * w], b0 = v[2 * ax + 1][2 * w] * r * g[2 * ax + 1][2 * w];
                        const float a1 = v[2 * ax][2 * w + 1] * r * g[2 * ax][2 * w + 1], b1 = v[2 * ax + 1][2 * w + 1] * r * g[2 * ax + 1][2 * w + 1];
                        oa[w] = pk2(a0 * cs2[0] - b0 * cs2[1], a1 * cs2[2] - b1 * cs2[3]);
                        ob[w] = pk2(b0 * cs2[0] + a0 * cs2[1], b1 * cs2[2] + a1 * cs2[3]);
                    }
                    y[2 * ax] = oa; y[2 * ax + 1] = ob;
                }
                bf16_t* dst = (hh < 8) ? QKV + (size_t)t * GQKV + hh * 128 + c4 * 8 : Kc + ((size_t)(hh - 8) * TT + t) * 128 + c4 * 8;
#pragma unroll
                for (int ch = 0; ch < 4; ++ch) *(u32x4*)(dst + ch * 32) = y[ch];
            }
          } }
    }
}

__device__ __forceinline__ s16x4 tr16(unsigned addr) {
    typedef short v4i16_t __attribute__((ext_vector_type(4)));
    return __builtin_bit_cast(s16x4, __builtin_amdgcn_ds_read_tr16_b64_v4i16((LAS v4i16_t*)addr));
}
__device__ __forceinline__ unsigned cvtpk(float lo, float hi) { unsigned r; asm volatile("v_cvt_pk_bf16_f32 %0, %1, %2" : "=v"(r) : "v"(lo), "v"(hi)); return r; }
struct NaUnit { int j, h, tok0, rows, r0, rs_lo, nchunks, kstart; };
__device__ __forceinline__ NaUnit na_decode(int unit) {
    NaUnit u; u.j = unit & 3; u.h = (unit >> 2) & 15; const int g = unit >> 6; int rc;
    if (g < 32) { u.tok0 = (g >> 2) * 2048; u.rows = 32; rc = g & 3; } else { u.tok0 = TP; u.rows = 256; rc = g - 32; }
    u.r0 = rc * 8;
    u.rs_lo = min(max(u.r0 - 4, 0), u.rows - 8); const int rs_hi = min(max(u.r0 + 3, 0), u.rows - 8);
    u.nchunks = (rs_hi + 8 - u.rs_lo) * 256;
    u.kstart = min(max(16 * u.j - 8, 0), 32);
    return u;
}
#define NA_LOAD(U) do { _Pragma("unroll") for (int i = 0; i < 8; ++i) { const int idx = tid + i * NTHREADS; \
            if (idx < (U).nchunks) { const int c = idx & 7, key = idx >> 3, krow = key >> 5, kcol = key & 31; \
                const size_t tok = (size_t)((U).tok0 + ((U).rs_lo + krow) * 64 + (U).kstart + kcol); \
                const bf16_t* src = QKV + tok * NAQKV + 1024 + (U).h * 64 + c * 8; \
                kreg[i] = *(const u32x4*)src; vreg[i] = *(const u32x4*)(src + 1024); } } \
        { const bf16_t* qp_ = QKV + (size_t)((U).tok0 + ((U).r0 + wid) * 64 + 16 * (U).j + n16) * NAQKV + (U).h * 64 + kq * 8; qn0 = *(const bf16x8*)qp_; qn1 = *(const bf16x8*)(qp_ + 32); } } while (0)
__device__ __forceinline__ void na_phase(LAS unsigned char* lds, const bf16_t* QKV, const float* rpb, bf16_t* O, int bid, int G) {
    constexpr int K_OFF = 0, V_OFF = 61440, B_OFF = 122880;
    const int tid = threadIdx.x, lane = tid & 63, wid = tid >> 6, n16 = lane & 15, kq = lane >> 4;
    LAS float* bias = (LAS float*)(lds + B_OFF);
    u32x4 kreg[8], vreg[8]; bf16x8 qn0, qn1;
    if (bid < 4096) { const NaUnit u0 = na_decode(bid); NA_LOAD(u0); }
    for (int unit = bid; unit < 4096; unit += G) {
        const NaUnit U = na_decode(unit);
        const int j = U.j, h = U.h, tok0 = U.tok0, rows = U.rows, r0 = U.r0, rs_lo = U.rs_lo, kstart = U.kstart;
#pragma unroll
        for (int i = 0; i < 8; ++i) { const int idx = tid + i * NTHREADS;
            if (idx < U.nchunks) { const int c = idx & 7, key = idx >> 3;
                *(LAS u32x4*)(lds + K_OFF + key * 128 + ((c ^ ((key >> 1) & 7)) << 4)) = kreg[i];
                *(LAS u32x4*)(lds + V_OFF + key * 128 + ((c ^ (((key >> 1) & 3) << 1)) << 4)) = vreg[i]; } }
        if (tid < 465) bias[(tid / 31) * 32 + (tid % 31)] = rpb[h * 465 + tid];
        if (tid >= 480 && tid < 495) bias[(tid - 480) * 32 + 31] = -1.0e30f;
        __syncthreads();
        const int r = r0 + wid, rs = min(max(r - 4, 0), rows - 8), lrow0 = rs - rs_lo;
        const int qcol = 16 * j + n16; const size_t qtok = (size_t)(tok0 + r * 64 + qcol);
        const bf16x8 q0 = qn0, q1 = qn1;
        if (unit + G < 4096) { const NaUnit Un = na_decode(unit + G); NA_LOAD(Un); }
        asm volatile("" ::: "memory");
        f32x4 s[16];
        const int ksw = (n16 >> 1) & 7;
        const LAS unsigned char* kp0 = lds + K_OFF + (lrow0 * 32 + n16) * 128;
        const LAS unsigned char* ka = kp0 + ((kq ^ ksw) << 4); const LAS unsigned char* kb = kp0 + (((4 + kq) ^ ksw) << 4);
#pragma unroll
        for (int t = 0; t < 16; ++t) {
            const bf16x8 k0 = *(const LAS bf16x8*)(ka + t * 2048), k1 = *(const LAS bf16x8*)(kb + t * 2048);
            f32x4 z = {0.f, 0.f, 0.f, 0.f};
            z = __builtin_amdgcn_mfma_f32_16x16x32_bf16(k0, q0, z, 0, 0, 0); z = __builtin_amdgcn_mfma_f32_16x16x32_bf16(k1, q1, z, 0, 0, 0); s[t] = z;
        }
        const int wstart = min(max(qcol - 8, 0), 48);
        int boff[2][4];
#pragma unroll
        for (int h2 = 0; h2 < 2; ++h2)
#pragma unroll
            for (int i = 0; i < 4; ++i) { const int kc = kstart + h2 * 16 + kq * 4 + i; const bool valid = (kc >= wstart) && (kc < wstart + 16); boff[h2][i] = valid ? (kc - qcol + 15) : 31; }
        const LAS float* brow0 = bias + (rs - r + 7) * 32;
        float mx = -3.0e38f;
#pragma unroll
        for (int t = 0; t < 16; ++t)
#pragma unroll
            for (int i = 0; i < 4; ++i) { const float v = s[t][i] + brow0[(t >> 1) * 32 + boff[t & 1][i]]; s[t][i] = v; mx = fmaxf(mx, v); }
        mx = fmaxf(mx, __shfl_xor(mx, 16)); mx = fmaxf(mx, __shfl_xor(mx, 32));
        const float mc = -mx * 1.4426950408889634f;
#pragma unroll
        for (int t = 0; t < 16; ++t)
#pragma unroll
            for (int i = 0; i < 4; ++i) s[t][i] = __builtin_amdgcn_exp2f(fmaf(s[t][i], 1.4426950408889634f, mc));
        f32x4 o[4], osum = (f32x4){0.f, 0.f, 0.f, 0.f};
#pragma unroll
        for (int dt = 0; dt < 4; ++dt) o[dt] = (f32x4){0.f, 0.f, 0.f, 0.f};
        const bf16x8 ones = (bf16x8){0x3F80, 0x3F80, 0x3F80, 0x3F80, 0x3F80, 0x3F80, 0x3F80, 0x3F80};
        const int q4 = n16 >> 2, p4 = n16 & 3;
        const int vsw = ((kq * 4 + q4) >> 1) & 3;
        const unsigned vbase = (unsigned)(uintptr_t)(lds + V_OFF) + (lrow0 * 32 + kq * 4 + q4) * 128 + p4 * 8;
        const unsigned va0 = vbase + ((0 ^ vsw) << 5), va1 = vbase + ((1 ^ vsw) << 5), va2 = vbase + ((2 ^ vsw) << 5), va3 = vbase + ((3 ^ vsw) << 5);
#pragma unroll
        for (int u = 0; u < 8; ++u) {
            u32x4 pw; pw.x = cvtpk(s[2 * u][0], s[2 * u][1]); pw.y = cvtpk(s[2 * u][2], s[2 * u][3]); pw.z = cvtpk(s[2 * u + 1][0], s[2 * u + 1][1]); pw.w = cvtpk(s[2 * u + 1][2], s[2 * u + 1][3]);
            const bf16x8 pf = __builtin_bit_cast(bf16x8, pw);
            osum = __builtin_amdgcn_mfma_f32_16x16x32_bf16(ones, pf, osum, 0, 0, 0);
#pragma unroll
            for (int dt = 0; dt < 4; ++dt) {
                const unsigned addr = (dt == 0 ? va0 : dt == 1 ? va1 : dt == 2 ? va2 : va3) + u * 4096;
                const s16x4 lo = tr16(addr), hi = tr16(addr + 2048);
                const bf16x8 vf = (bf16x8){lo[0], lo[1], lo[2], lo[3], hi[0], hi[1], hi[2], hi[3]};
                o[dt] = __builtin_amdgcn_mfma_f32_16x16x32_bf16(vf, pf, o[dt], 0, 0, 0);
            }
        }
        const float l = osum[0];
        const float inv = 1.0f / l;
        bf16_t* op = O + qtok * DM + h * 64 + kq * 4;
#pragma unroll
        for (int dt = 0; dt < 4; ++dt) { u32x2 w; w.x = cvtpk(o[dt][0] * inv, o[dt][1] * inv); w.y = cvtpk(o[dt][2] * inv, o[dt][3] * inv); *(u32x2*)(op + dt * 16) = w; }
        __syncthreads();
    }
}

#define XB_TMO      128
#define XB_XCNT(j)  (256  + 64 * (j))
#define XB_XSUB(j)  (1280 + 64 * (j))
#define XB_XGEN(j)  (2304 + 64 * (j))
#define XB_TOP      3328
#define XB_TOPGEN   3392
#define XCD_BAR_WORDS 3456
#define XB_SPIN_CAP (1u << 21)

__device__ __forceinline__ unsigned xb_ld(unsigned* p)              { return __hip_atomic_load(p, __ATOMIC_RELAXED, __HIP_MEMORY_SCOPE_AGENT); }
__device__ __forceinline__ unsigned xb_add(unsigned* p, unsigned v) { return __hip_atomic_fetch_add(p, v, __ATOMIC_RELAXED, __HIP_MEMORY_SCOPE_AGENT); }
__device__ __forceinline__ unsigned xb_xcc_id() { return (unsigned)__builtin_amdgcn_s_getreg((3 << 11) | 20) & 0xFu; }
#define XB_SPIN(cond, bar) do { unsigned _sp = 0; while (cond) { __builtin_amdgcn_s_sleep(1); \
    if ((++_sp & 255u) == 0u) { if (xb_ld(&(bar)[XB_TMO])) break; if (_sp > XB_SPIN_CAP) { atomicAdd(&(bar)[XB_TMO], 1u); break; } } } } while (0)

struct XcdBarrier {
    unsigned* bar; unsigned x;
    volatile LAS unsigned* st;
};

__device__ __forceinline__ XcdBarrier xcd_barrier_post(unsigned* bar, volatile LAS unsigned* st) {
    XcdBarrier b; b.bar = bar; b.x = xb_xcc_id(); b.st = st;
    if (threadIdx.x == 0) (void)xb_add(&bar[XB_XCNT(b.x)], 1u);
    return b;
}
__device__ __forceinline__ void xcd_barrier_complete(unsigned* bar, unsigned x, unsigned& nloc, unsigned& nx) {
    const unsigned G = gridDim.x * gridDim.y * gridDim.z;
    unsigned sum, cnt, mine, sp = 0u;
    for (;;) {
        sum = 0u; cnt = 0u; mine = 0u;
#pragma unroll
        for (unsigned j = 0; j < 16; ++j) { const unsigned c = xb_ld(&bar[XB_XCNT(j)]); sum += c; cnt += (c > 0u) ? 1u : 0u; mine = (j == x) ? c : mine; }
        if (sum == G) break;
        __builtin_amdgcn_s_sleep(1);
        if ((++sp & 255u) == 0u) { if (xb_ld(&bar[XB_TMO])) break; if (sp > XB_SPIN_CAP) { atomicAdd(&bar[XB_TMO], 1u); break; } }
    }
    nloc = mine > 0u ? mine : 1u; nx = cnt > 0u ? cnt : 1u;
}

__device__ __forceinline__ void xcd_barrier(const XcdBarrier& b) {
    asm volatile("s_waitcnt vmcnt(0)" ::: "memory");
    __syncthreads();
    if (threadIdx.x == 0) {
        unsigned* bar = b.bar;
        __builtin_amdgcn_s_waitcnt(0);
        unsigned nloc = b.st[0], nx = b.st[1];
        if (nloc == 0u) { xcd_barrier_complete(bar, b.x, nloc, nx); b.st[0] = nloc; b.st[1] = nx; }
        const unsigned old = xb_add(&bar[XB_XSUB(b.x)], 1u);
        const unsigned gen = old / nloc;
        if (old + 1u == (gen + 1u) * nloc) {
            __builtin_amdgcn_fence(__ATOMIC_RELEASE, "agent");
            asm volatile("s_waitcnt vmcnt(0)" ::: "memory");
            const unsigned og = xb_add(&bar[XB_TOP], 1u);
            const unsigned tg = og / nx;
            if (og + 1u == (tg + 1u) * nx) xb_add(&bar[XB_TOPGEN], 1u);
            else XB_SPIN(xb_ld(&bar[XB_TOPGEN]) == tg, bar);
            __builtin_amdgcn_fence(__ATOMIC_ACQUIRE, "agent");
            xb_add(&bar[XB_XGEN(b.x)], 1u);
            asm volatile("s_waitcnt vmcnt(0)" ::: "memory");
        } else {
            XB_SPIN(xb_ld(&bar[XB_XGEN(b.x)]) == gen, bar);
            __builtin_amdgcn_fence(__ATOMIC_ACQUIRE, "agent");
            asm volatile("s_waitcnt vmcnt(0)" ::: "memory");
        }
    }
    __syncthreads();
}

struct Args { const float* in[19]; float* out; unsigned char* ws; int ph_lo, ph_hi; };

__global__ void __launch_bounds__(NTHREADS, 2) mega_fwd(Args a) {
    extern __shared__ __attribute__((aligned(16))) unsigned char lds_raw[];
    LAS unsigned char* lds = (LAS unsigned char*)lds_raw;
    cg::grid_group grid = cg::this_grid();
    const int tid = threadIdx.x, lane = tid & 63, wave = __builtin_amdgcn_readfirstlane(tid >> 6);
    const int G = gridDim.x, bid = blockIdx.x;
    const int gw = bid * NWAVES + wave, ngw = G * NWAVES;
    unsigned char* ws = a.ws;
    bf16_t* Abuf = (bf16_t*)(ws + WS_A); bf16_t* QKV = (bf16_t*)(ws + WS_QKV); bf16_t* ACT = QKV; bf16_t* Obuf = (bf16_t*)(ws + WS_O); bf16_t* PPb = Obuf;
    bf16_t* Hb = (bf16_t*)(ws + WS_MB); bf16_t* PB = (bf16_t*)(ws + WS_PB);
    bf16_t* MB = (bf16_t*)a.out;
    volatile LAS unsigned* MISC = (volatile LAS unsigned*)(lds + MISC_OFF);
    if (tid < 2) MISC[tid] = 0u;
    unsigned* barw = (unsigned*)(ws + WS_CTL);
    __syncthreads();
    XcdBarrier bar = xcd_barrier_post(barw, MISC);

    const int lo = a.ph_lo, hi = a.ph_hi;
    if (hi > 1000) grid.sync();
#define IN(k) (lo <= (k) && (k) < hi)
#define SEAM(k) do { if ((k) + 1 < hi) xcd_barrier(bar); } while (0)
#define GEMM_STORE(Aptr, Bptr, Nn, Kk, Optr, Ldc, Qcols) do { pg8::Gemm g{(Aptr), (Bptr), TT, (Nn), (Kk)}; pg8::StaticOrder S; S.init(TT, (Nn), G, bid); \
        pg8::EpiStore<false> E{(Optr), (Ldc), (Qcols), 0.125f, nullptr}; pg8::gemm_phase<pg8::EpiStore<false>, pg8::StaticOrder, true, true>(lds, g, S, E); } while (0)
#define GEMM_STORE_RS(Aptr, Bptr, Nn, Kk, Optr, Ldc, SSp) do { pg8::Gemm g{(Aptr), (Bptr), TT, (Nn), (Kk)}; pg8::StaticOrder S; S.init(TT, (Nn), G, bid); \
        pg8::EpiStore<true> E{(Optr), (Ldc), 0, 1.0f, (SSp)}; pg8::gemm_phase<pg8::EpiStore<true>, pg8::StaticOrder, true, true>(lds, g, S, E); } while (0)
#define GEMM_SWIGLU(Bptr) do { pg8::Gemm g{Abuf, (Bptr), TT, 2 * DFF, DM}; pg8::StaticOrder S; S.init(TT, 2 * DFF, G, bid); \
        pg8::EpiSwiglu E{ACT, DFF}; pg8::gemm_phase<pg8::EpiSwiglu, pg8::StaticOrder, true, true>(lds, g, S, E); } while (0)
#define GEMM_GATE(Bptr, MODE) do { pg8::Gemm g{Abuf, (Bptr), TT, DM, DM}; pg8::StaticOrder S; S.init(TT, DM, G, bid); \
        pg8::EpiGate<MODE> E{Hb, PPb, Hb, a.out, (bf16_t*)(ws + WS_A2), a.in[4] + DM, (float*)(ws + WS_SS)}; pg8::gemm_phase<pg8::EpiGate<MODE>, pg8::StaticOrder, true, true>(lds, g, S, E); } while (0)
#define WPTR(off) ((const bf16_t*)(ws + (off)))
#ifndef PROBE_REP
#define PROBE_REP 0
#endif
#define REP(k) for (int rep_ = 0; rep_ < (((PROBE_REP >> (k)) & 1) ? 2 : 1); ++rep_)
#define REPBAR(k) do { if (((PROBE_REP >> (k)) & 1) && rep_ == 0) xcd_barrier(bar); } while (0)

    if (IN(0)) { REP(0) {
        LAS float* scr = (LAS float*)(lds + wave * 16384);
        constexpr int I0 = 16 * 96, I1 = 16 * 32, I2 = 16 * 64, I3 = 16 * 32, I4 = 16 * 176, I6 = 44 * 32, I8 = 16 * 32, I10 = 4 * 32;
        constexpr int NITEMS = I0 + I1 + I2 + I3 + 2 * I4 + 2 * I6 + 2 * I8 + 2 * I10;
#define T_DECODE(D, IT) do { int r = (IT); \
            if (r < I0) { D = TItem{a.in[8], (bf16_t*)(ws + WS_W_NAQKV), DM, NAQKV, r, 0}; } else { r -= I0; \
            if (r < I1) { D = TItem{a.in[10], (bf16_t*)(ws + WS_W_NAO), DM, DM, r, 0}; } else { r -= I1; \
            if (r < I2) { D = TItem{a.in[11], (bf16_t*)(ws + WS_W_GQKV), DM, GQKV, r, 0}; } else { r -= I2; \
            if (r < I3) { D = TItem{a.in[14], (bf16_t*)(ws + WS_W_GO), DM, DM, r, 0}; } else { r -= I3; \
            if (r < 2 * I4) { const int l = r / I4; D = TItem{a.in[15] + (size_t)l * DM * 2 * DFF, (bf16_t*)(ws + WS_W_GU + l * SZ_W_GU), DM, 2 * DFF, r % I4, 1}; } else { r -= 2 * I4; \
            if (r < 2 * I6) { const int l = r / I6; D = TItem{a.in[16] + (size_t)l * DFF * DM, (bf16_t*)(ws + WS_W_DN + l * SZ_W_DN), DFF, DM, r % I6, 0}; } else { r -= 2 * I6; \
            if (r < 2 * I8) { const int l = r / I8; D = TItem{a.in[17] + (size_t)l * DM * DM, (bf16_t*)(ws + WS_W_PG + l * SZ_W_SQ), DM, DM, r % I8, 0}; } else { r -= 2 * I8; \
            { const int l = r / I10; D = TItem{a.in[18] + (size_t)l * PLE * DM, (bf16_t*)(ws + WS_W_PP + l * SZ_W_PP), PLE, DM, r % I10, 0}; } } } } } } } } } while (0)
        { float tv[32]; TItem dn{};
          if (gw < NITEMS) { T_DECODE(dn, gw); t_load(dn, lane, tv); }
          for (int it = gw; it < NITEMS; it += ngw) {
              const TItem dc = dn;
              t_stage(lane, tv, scr);
              if (it + ngw < NITEMS) { T_DECODE(dn, it + ngw); t_load(dn, lane, tv); }
              t_store(dc, lane, scr);
          } }
#undef T_DECODE
        rowpass<true>(gw, ngw, lane, a.in[0], a.in[1], nullptr, nullptr, nullptr, nullptr, a.in[4], Abuf);
        for (size_t i = (size_t)bid * NTHREADS + tid; i < (size_t)2 * TT * PLE / 8; i += (size_t)G * NTHREADS) {
            const size_t e = i * 8, l = e / ((size_t)TT * PLE), rem = e % ((size_t)TT * PLE);
            const float* src = (rem < (size_t)TP * PLE) ? a.in[2] + l * (size_t)TP * PLE + rem : a.in[3] + l * (size_t)TP * PLE + (rem - (size_t)TP * PLE);
            const f32x4 x0 = *(const f32x4*)src, x1 = *(const f32x4*)(src + 4);
            u32x4 w; w.x = pk2(x0[0], x0[1]); w.y = pk2(x0[2], x0[3]); w.z = pk2(x1[0], x1[1]); w.w = pk2(x1[2], x1[3]);
            *(u32x4*)(PB + e) = w;
        }
        for (int i = bid * NTHREADS + tid; i < TT; i += G * NTHREADS) ((float*)(ws + WS_SS))[i] = 0.f;
        { const int gi = bid * NTHREADS + tid;
          if (gi < 8192) { const int pos = gi >> 5, f = gi & 31;
              const float inv_freq = __builtin_amdgcn_exp2f(-(float)f * (13.287712379549449f / 32.0f));
              const float ang = (float)pos * inv_freq;
              double rev = (double)ang * 0.15915494309189535; rev -= __builtin_rint(rev); const float revf = (float)rev;
              float* tp = (float*)(ws + WS_TAB) + gi * 2; tp[0] = __builtin_amdgcn_cosf(revf); tp[1] = __builtin_amdgcn_sinf(revf); } }
        if (((PROBE_REP >> 0) & 1) && rep_ == 0) xcd_barrier(bar); }
        SEAM(0);
    }
    if (IN(1)) { GEMM_STORE(Abuf, WPTR(WS_W_NAQKV), NAQKV, DM, QKV, NAQKV, 1024); SEAM(1); }
    if (IN(2)) { REP(2) { na_phase(lds, QKV, a.in[9], Obuf, bid, G); REPBAR(2); } SEAM(2); }
    if (IN(3)) { if ((PROBE_REP >> 3) & 1) { GEMM_STORE(Obuf, WPTR(WS_W_NAO), DM, DM, MB, DM, 0); xcd_barrier(bar); }
        GEMM_STORE(Obuf, WPTR(WS_W_NAO), DM, DM, MB, DM, 0); SEAM(3); }
    if (IN(4)) { REP(4) { rowpass<true>(gw, ngw, lane, a.in[0], a.in[1], nullptr, Hb, MB, a.in[5], a.in[6], Abuf); REPBAR(4); } SEAM(4); }
    if (IN(5)) { if ((PROBE_REP >> 5) & 1) { GEMM_SWIGLU(WPTR(WS_W_GU)); xcd_barrier(bar); }
        GEMM_SWIGLU(WPTR(WS_W_GU)); SEAM(5); }
    if (IN(6)) { GEMM_STORE(ACT, WPTR(WS_W_DN), DM, DFF, MB, DM, 0); GEMM_STORE(PB, WPTR(WS_W_PP), DM, PLE, PPb, DM, 0); SEAM(6); }
    if (IN(7)) { rowpass<false>(gw, ngw, lane, nullptr, nullptr, Hb, Hb, MB, a.in[7], nullptr, Abuf); SEAM(7); }
    if (IN(8)) { GEMM_GATE(WPTR(WS_W_PG), 2); SEAM(8); }
    if (IN(10)) { GEMM_STORE_RS((const bf16_t*)(ws + WS_A2), WPTR(WS_W_GQKV), GQKV, DM, QKV, GQKV, (const float*)(ws + WS_SS)); SEAM(10); }
    if (IN(11)) { qk_norm_rope(gw, ngw, lane, QKV, (bf16_t*)(ws + WS_KC), (bf16_t*)(ws + WS_VC), (const float*)(ws + WS_TAB), a.in[12], a.in[13]); SEAM(11); }
    if (IN(12)) {
        REP(12) {
        for (int k = bid; k < 1024; k += G) {
            int rowbase, kvbase, seq, h;
            if (k < 512) { h = k & 7; const int qb = k >> 3; rowbase = TP + qb * 256; kvbase = TP; seq = 16384; }
            else { const int k2 = k - 512, b = k2 & 7, s = k2 >> 3; h = s >> 3; const int qb = s & 7; rowbase = b * 2048 + qb * 256; kvbase = b * 2048; seq = 2048; }
            const att::bf16* Q = (const att::bf16*)QKV;
            att::attn_dense_body<att::bf16>(Q + (size_t)rowbase * GQKV + h * 128, (const att::bf16*)(ws + WS_KC) + ((size_t)(h >> 1) * TT + kvbase) * 128, (const att::bf16*)(ws + WS_VC) + ((size_t)(h >> 1) * TT + kvbase) * 128,
                                            (att::bf16*)Obuf + (size_t)rowbase * DM + h * 128, seq, (char*)lds_raw);
            __syncthreads();
        }
        REPBAR(12); }
        SEAM(12);
    }
    if (IN(13)) { GEMM_STORE(Obuf, WPTR(WS_W_GO), DM, DM, MB, DM, 0); SEAM(13); }
    if (IN(14)) { rowpass<false>(gw, ngw, lane, nullptr, nullptr, Hb, Hb, MB, a.in[5] + DM, a.in[6] + DM, Abuf); SEAM(14); }
    if (IN(15)) { GEMM_SWIGLU(WPTR(WS_W_GU + SZ_W_GU)); SEAM(15); }
    if (IN(16)) { GEMM_STORE(ACT, WPTR(WS_W_DN + SZ_W_DN), DM, DFF, MB, DM, 0); GEMM_STORE(PB + (size_t)TT * PLE, WPTR(WS_W_PP + SZ_W_PP), DM, PLE, PPb, DM, 0); SEAM(16); }
    if (IN(17)) { rowpass<false>(gw, ngw, lane, nullptr, nullptr, Hb, Hb, MB, a.in[7] + DM, nullptr, Abuf); SEAM(17); }
    if (IN(18)) { GEMM_GATE(WPTR(WS_W_PG + SZ_W_SQ), 1); }
#undef IN
#undef SEAM
}

extern "C" void kernel_launch(void* const* d_in, const int* in_sizes, int n_in, void* d_out, int out_size, void* d_ws, size_t ws_size, hipStream_t stream) {
    static int grid = 0;
    if (grid == 0) {
        if (n_in != 19 || out_size != TT * DM || ws_size < WS_END) { fprintf(stderr, "kernel_launch: unexpected shapes (n_in %d out %d ws %zu)\n", n_in, out_size, ws_size); grid = -1; return; }
        int dev = 0, cus = 0, per_cu = 0;
        if (hipGetDevice(&dev) != hipSuccess || hipDeviceGetAttribute(&cus, hipDeviceAttributeMultiprocessorCount, dev) != hipSuccess) { grid = -1; return; }
        if (hipFuncSetAttribute((const void*)mega_fwd, hipFuncAttributeMaxDynamicSharedMemorySize, LDS_BYTES) != hipSuccess) { fprintf(stderr, "kernel_launch: hipFuncSetAttribute failed\n"); grid = -1; return; }
        if (hipOccupancyMaxActiveBlocksPerMultiprocessor(&per_cu, (const void*)mega_fwd, NTHREADS, LDS_BYTES) != hipSuccess || per_cu < 1) { fprintf(stderr, "kernel_launch: occupancy query says %d\n", per_cu); per_cu = 1; }
        (void)hipGetLastError();
        grid = cus * 1;
        if (grid > 256) grid = 256;
    }
    if (grid < 0) return;
    if (hipMemsetAsync((char*)d_ws + WS_CTL, 0, 16384, stream) != hipSuccess) { fprintf(stderr, "kernel_launch: hipMemsetAsync failed\n"); return; }
    Args a{};
    for (int i = 0; i < 19; ++i) a.in[i] = (const float*)d_in[i];
    a.out = (float*)d_out; a.ws = (unsigned char*)d_ws;
#if MK_PER_PHASE
    for (int ph = 0; ph < N_PHASES; ++ph) {
        a.ph_lo = ph; a.ph_hi = ph + 1;
        hipLaunchKernelGGL(mega_fwd, dim3(grid), dim3(NTHREADS), LDS_BYTES, stream, a);
    }
#else
    a.ph_lo = 0; a.ph_hi = N_PHASES;
    void* args[] = {&a};
    hipError_t e = hipLaunchCooperativeKernel((const void*)mega_fwd, dim3(grid), dim3(NTHREADS), args, LDS_BYTES, stream);
    if (e != hipSuccess) fprintf(stderr, "kernel_launch: cooperative launch failed: %s (grid %d)\n", hipGetErrorString(e), grid);
#endif
    const hipError_t le = hipPeekAtLastError();
    if (le != hipSuccess) fprintf(stderr, "kernel_launch: launch failed: %s\n", hipGetErrorName(le));
}
```
